# Optimizing an MI355X kernel written in HIP

```python
import jax
import jax.numpy as jnp
from jax import lax
import numpy as np

D_MODEL = 2048
BATCH = 16
SEQ = 2048
DEPTH = 4

N_GROUPS = 4
GROUP_WIDTH = D_MODEL // N_GROUPS
HEAD_DIM = 64
N_HEADS = GROUP_WIDTH // HEAD_DIM
D_FF = ((8 * D_MODEL + 3 * 256 - 1) // (3 * 256)) * 256

RET_CHUNK = 128
HGRN_CHUNK = 32
MLSTM_CHUNK = 64
CONV_WIDTH = 4
ROPE_BASE = 10000.0
RWKV_W_LORA = 64
RWKV_A_LORA = 64
RWKV_V_LORA = 32
RWKV_G_LORA = 128
RWKV_DECAY_SCALE = 0.6065306597126334
RWKV_LN_EPS = 64e-5
NORM_EPS = 1e-6

RET_SPLIT = (GROUP_WIDTH,) * 4
HGRN_SPLIT = (GROUP_WIDTH,) * 4
MLSTM_SPLIT = (GROUP_WIDTH,) * 4 + (N_HEADS, N_HEADS)
RWKV_SPLIT = (GROUP_WIDTH,) * 3 + (RWKV_W_LORA, RWKV_A_LORA, RWKV_G_LORA)
GROUP_COLS = (sum(RET_SPLIT), sum(HGRN_SPLIT), sum(MLSTM_SPLIT), sum(RWKV_SPLIT))
N_IN = sum(GROUP_COLS)

kernel_name = 'hybrid_parallel_groups_trunk'


def split_cols(t, sizes):
    return jnp.split(t, [int(i) for i in np.cumsum(sizes)[:-1]], axis=-1)


def rms_norm(x, w):
    xf = x.astype(jnp.float32)
    y = xf * lax.rsqrt(jnp.mean(xf * xf, axis=-1, keepdims=True) + NORM_EPS)
    return (y * w.astype(jnp.float32)).astype(x.dtype)


def to_heads(t):
    return t.reshape(t.shape[0], t.shape[1], N_HEADS, HEAD_DIM).transpose(0, 2, 1, 3)


def from_heads(t):
    return t.transpose(0, 2, 1, 3)


def head_rms(t, w=None):
    y = t * lax.rsqrt(jnp.mean(t * t, axis=-1, keepdims=True) + NORM_EPS)
    if w is not None:
        y = y * w.reshape(N_HEADS, HEAD_DIM)
    return y.reshape(t.shape[0], t.shape[1], -1)


def to_chunks(t, c):
    b, h, s = t.shape[:3]
    return jnp.moveaxis(t.reshape(b, h, s // c, c, *t.shape[3:]), 2, 0)


def from_chunks(t):
    t = jnp.moveaxis(t, 0, 2)
    return t.reshape(t.shape[0], t.shape[1], -1, t.shape[-1])


def rotary(t, pos):
    half = HEAD_DIM // 2
    inv_freq = ROPE_BASE ** (-jnp.arange(half, dtype=jnp.float32) / half)
    ang = pos[:, None] * inv_freq[None, :]
    cos, sin = jnp.cos(ang), jnp.sin(ang)
    t1, t2 = t[..., :half], t[..., half:]
    return jnp.concatenate([t1 * cos - t2 * sin, t1 * sin + t2 * cos], axis=-1)


def token_shift(t):
    return jnp.pad(t, ((0, 0), (1, 0), (0, 0)))[:, :-1]


def causal_dwconv(t, w, b):
    seq = t.shape[1]
    tp = jnp.pad(t, ((0, 0), (CONV_WIDTH - 1, 0), (0, 0)))
    out = b + tp[:, 0:seq] * w[0]
    for j in range(1, CONV_WIDTH):
        out = out + tp[:, j:j + seq] * w[j]
    return out


def chunked_retention(q, k, v):
    c = RET_CHUNK
    b, h, s, d = q.shape
    log_gamma = jnp.log1p(-jnp.exp2(-5.0 - jnp.arange(h, dtype=jnp.float32)))
    idx = jnp.arange(c, dtype=jnp.float32)
    rel = idx[:, None] - idx[None, :]
    intra = jnp.where(rel >= 0, jnp.exp(log_gamma[:, None, None] * jnp.maximum(rel, 0.0)), 0.0)
    q_dec = jnp.exp(log_gamma[:, None] * (idx + 1.0))[:, :, None]
    k_dec = jnp.exp(log_gamma[:, None] * (c - 1.0 - idx))[:, :, None]
    chunk_dec = jnp.exp(log_gamma * c)[:, None, None]

    def step(state, inp):
        qc, kc, vc = inp
        scores = jnp.einsum('bhtd,bhsd->bhts', qc, kc) * intra
        out = (jnp.einsum('bhts,bhse->bhte', scores, vc)
               + jnp.einsum('bhtd,bhde->bhte', qc * q_dec, state))
        state = chunk_dec * state + jnp.einsum('bhsd,bhse->bhde', kc * k_dec, vc)
        return state, out

    _, o = lax.scan(step, jnp.zeros((b, h, d, d), q.dtype),
                    (to_chunks(q, c), to_chunks(k, c), to_chunks(v, c)))
    return from_chunks(o)


def retention_group(p):
    q, k, v, g = split_cols(p, RET_SPLIT)
    pos = jnp.arange(p.shape[1], dtype=jnp.float32)
    qh = rotary(to_heads(q), pos)
    kh = rotary(to_heads(k), pos) * HEAD_DIM ** -0.5
    o = chunked_retention(qh, kh, to_heads(v))
    return head_rms(from_heads(o)) * jax.nn.silu(g)


def chunked_hgrn2(q, k, v, log_f):
    c = HGRN_CHUNK
    b, h, s, dk = q.shape
    dv = v.shape[-1]
    causal = jnp.tril(jnp.ones((c, c), dtype=bool))[:, :, None]

    def step(state, inp):
        qc, kc, vc, gc = inp
        cum = jnp.cumsum(gc, axis=2)
        pair = jnp.where(causal,
                         jnp.exp(jnp.minimum(cum[:, :, :, None, :] - cum[:, :, None, :, :], 0.0)), 0.0)
        scores = jnp.einsum('bhtd,bhsd,bhtsd->bhts', qc, kc, pair)
        out = (jnp.einsum('bhts,bhse->bhte', scores, vc)
               + jnp.einsum('bhtd,bhde->bhte', qc * jnp.exp(cum), state))
        cum_end = cum[:, :, -1:, :]
        state = (jnp.exp(cum_end)[:, :, 0, :, None] * state
                 + jnp.einsum('bhsd,bhse->bhde', kc * jnp.exp(cum_end - cum), vc))
        return state, out

    _, o = lax.scan(step, jnp.zeros((b, h, dk, dv), q.dtype),
                    (to_chunks(q, c), to_chunks(k, c), to_chunks(v, c), to_chunks(log_f, c)))
    return from_chunks(o)


def hgrn2_group(p, lb, norm_w):
    q, f, i, g = split_cols(p, HGRN_SPLIT)
    log_f = jnp.logaddexp(jnp.log(lb), jnp.log1p(-lb) + jax.nn.log_sigmoid(f))
    k = (1.0 - lb) * jax.nn.sigmoid(-f)
    o = chunked_hgrn2(to_heads(jax.nn.silu(q)) * HEAD_DIM ** -0.5, to_heads(k), to_heads(i), to_heads(log_f))
    return head_rms(from_heads(o), norm_w) * jax.nn.sigmoid(g)


def chunked_mlstm(q, k, v, log_i, log_f):
    c = MLSTM_CHUNK
    b, h, s, dk = q.shape
    dv = v.shape[-1]
    causal = jnp.tril(jnp.ones((c, c), dtype=bool))

    def step(carry, inp):
        cmem, nvec, m = carry
        qc, kc, vc, ic, fc = inp
        cum = jnp.cumsum(fc, axis=-1)
        logd = jnp.where(causal, cum[..., :, None] - cum[..., None, :] + ic[..., None, :], -jnp.inf)
        log_inter = cum + m[..., None]
        m_t = jnp.maximum(jnp.max(logd, axis=-1), log_inter)
        scores = jnp.einsum('bhtd,bhsd->bhts', qc, kc) * jnp.exp(logd - m_t[..., None])
        w_inter = jnp.exp(log_inter - m_t)
        num = (jnp.einsum('bhts,bhse->bhte', scores, vc)
               + w_inter[..., None] * jnp.einsum('bhtd,bhde->bhte', qc, cmem))
        den = jnp.sum(scores, axis=-1) + w_inter * jnp.einsum('bhtd,bhd->bht', qc, nvec)
        h_out = num / jnp.maximum(jnp.abs(den), jnp.exp(-m_t))[..., None]
        cum_end = cum[..., -1]
        log_w = cum_end[..., None] - cum + ic
        m_new = jnp.maximum(cum_end + m, jnp.max(log_w, axis=-1))
        decay = jnp.exp(cum_end + m - m_new)
        kw = kc * jnp.exp(log_w - m_new[..., None])[..., None]
        cmem = decay[..., None, None] * cmem + jnp.einsum('bhsd,bhse->bhde', kw, vc)
        nvec = decay[..., None] * nvec + jnp.sum(kw, axis=2)
        return (cmem, nvec, m_new), h_out

    init = (jnp.zeros((b, h, dk, dv), q.dtype), jnp.zeros((b, h, dk), q.dtype), jnp.zeros((b, h), q.dtype))
    _, o = lax.scan(step, init, (to_chunks(q, c), to_chunks(k, c), to_chunks(v, c),
                                 to_chunks(log_i, c), to_chunks(log_f, c)))
    return from_chunks(o)


def mlstm_group(p, conv_w, conv_b, i_bias, f_bias, norm_w):
    q, k, v, o, ig, fg = split_cols(p, MLSTM_SPLIT)
    qk = jax.nn.silu(causal_dwconv(jnp.concatenate([q, k], axis=-1), conv_w, conv_b))
    q, k = jnp.split(qk, 2, axis=-1)
    log_i = jnp.swapaxes(ig + i_bias, 1, 2)
    log_f = jnp.swapaxes(jax.nn.log_sigmoid(fg + f_bias), 1, 2)
    hm = chunked_mlstm(to_heads(q), to_heads(k) * HEAD_DIM ** -0.5, to_heads(v), log_i, log_f)
    return jax.nn.sigmoid(o) * head_rms(from_heads(hm), norm_w)


def rwkv7_scan(r, log_w, k, v, kk, a):
    b, s, h, d = r.shape
    xs = tuple(jnp.swapaxes(t, 0, 1) for t in (r, log_w, k, v, kk, a))

    def step(state, inp):
        rt, lwt, kt, vt, kkt, at = inp
        state = (state * jnp.exp(lwt)[:, :, None, :]
                 - jnp.einsum('bhvk,bhk->bhv', state, kkt)[..., None] * (at * kkt)[:, :, None, :]
                 + vt[..., None] * kt[:, :, None, :])
        return state, jnp.einsum('bhvk,bhk->bhv', state, rt)

    _, y = lax.scan(step, jnp.zeros((b, h, d, d), r.dtype), xs)
    return jnp.swapaxes(y, 0, 1)


def rwkv7_group(p, v_first, mu, w0, w_up, a0, a_up, g_up, k_k, k_a, r_k, ln_w, ln_b, vmix):
    b, s, _ = p.shape
    p = p + (token_shift(p) - p) * mu
    r, k, v, wd, ad, gd = split_cols(p, RWKV_SPLIT)
    log_w = -RWKV_DECAY_SCALE * jax.nn.sigmoid(w0 + jnp.tanh(wd) @ w_up)
    a = jax.nn.sigmoid(a0 + ad @ a_up)
    g = jax.nn.sigmoid(gd) @ g_up
    if vmix is None:
        v_first = v
    else:
        v0, v_down, v_up = vmix
        v = v + (v_first - v) * jax.nn.sigmoid(v0 + (v @ v_down) @ v_up)

    def hs(t):
        return t.reshape(b, s, N_HEADS, HEAD_DIM)

    kk = hs(k * k_k)
    kk = kk / jnp.maximum(jnp.sqrt(jnp.sum(kk * kk, axis=-1, keepdims=True)), 1e-12)
    k = k * (1.0 + (a - 1.0) * k_a)
    y = rwkv7_scan(hs(r), hs(log_w), hs(k), hs(v), kk, hs(a))
    mean = jnp.mean(y, axis=-1, keepdims=True)
    var = jnp.mean(jnp.square(y - mean), axis=-1, keepdims=True)
    y = ((y - mean) * lax.rsqrt(var + RWKV_LN_EPS)).reshape(b, s, -1) * ln_w + ln_b
    bonus = (jnp.sum(hs(r * k * r_k), axis=-1, keepdims=True) * hs(v)).reshape(b, s, -1)
    return (y + bonus) * g, v_first


def setup_inputs(seed: int = 0) -> dict:
    key = jax.random.key(seed)
    keys = jax.random.split(key, 31)
    counter = iter(range(31))
    G, H, L = GROUP_WIDTH, N_HEADS, DEPTH

    def nrm(shape, scale):
        return scale * jax.random.normal(keys[next(counter)], shape, jnp.float32)

    def gain(shape):
        return 1.0 + nrm(shape, 0.05)

    return {
        'x': nrm((BATCH, SEQ, D_MODEL), 1.0),
        'w_in': nrm((L, D_MODEL, N_IN), D_MODEL ** -0.5),
        'w_out': nrm((L, D_MODEL, D_MODEL), D_MODEL ** -0.5),
        'norm_pre_mix': gain((L, D_MODEL)),
        'norm_post_mix': gain((L, D_MODEL)),
        'norm_pre_ffn': gain((L, D_MODEL)),
        'norm_post_ffn': gain((L, D_MODEL)),
        'w_ffn_gate': nrm((L, D_MODEL, D_FF), D_MODEL ** -0.5),
        'w_ffn_up': nrm((L, D_MODEL, D_FF), D_MODEL ** -0.5),
        'w_ffn_down': nrm((L, D_FF, D_MODEL), D_FF ** -0.5),
        'hgrn_lb_logits': nrm((L, G), 0.5),
        'hgrn_norm_w': gain((L, G)),
        'mlstm_conv_w': nrm((L, CONV_WIDTH, 2 * G), CONV_WIDTH ** -0.5),
        'mlstm_conv_b': nrm((L, 2 * G), 0.02),
        'mlstm_i_bias': nrm((L, H), 0.1) - 1.0,
        'mlstm_f_bias': nrm((L, H), 0.5) + 3.0,
        'mlstm_norm_w': gain((L, G)),
        'rwkv_mu': jax.random.uniform(keys[next(counter)], (L, GROUP_COLS[3]), jnp.float32),
        'rwkv_w0': nrm((L, G), 0.5),
        'rwkv_w_up': nrm((L, RWKV_W_LORA, G), 0.5 * RWKV_W_LORA ** -0.5),
        'rwkv_a0': nrm((L, G), 0.5),
        'rwkv_a_up': nrm((L, RWKV_A_LORA, G), 0.5 * RWKV_A_LORA ** -0.5),
        'rwkv_g_up': nrm((L, RWKV_G_LORA, G), RWKV_G_LORA ** -0.5),
        'rwkv_k_k': gain((L, G)),
        'rwkv_k_a': gain((L, G)),
        'rwkv_r_k': nrm((L, G), 0.1),
        'rwkv_ln_w': gain((L, G)),
        'rwkv_ln_b': nrm((L, G), 0.02),
        'rwkv_v0': nrm((L - 1, G), 0.5),
        'rwkv_v_down': nrm((L - 1, G, RWKV_V_LORA), G ** -0.5),
        'rwkv_v_up': nrm((L - 1, RWKV_V_LORA, G), 0.5 * RWKV_V_LORA ** -0.5),
    }


def reference(x, w_in, w_out, norm_pre_mix, norm_post_mix, norm_pre_ffn, norm_post_ffn,
              w_ffn_gate, w_ffn_up, w_ffn_down, hgrn_lb_logits, hgrn_norm_w,
              mlstm_conv_w, mlstm_conv_b, mlstm_i_bias, mlstm_f_bias, mlstm_norm_w,
              rwkv_mu, rwkv_w0, rwkv_w_up, rwkv_a0, rwkv_a_up, rwkv_g_up,
              rwkv_k_k, rwkv_k_a, rwkv_r_k, rwkv_ln_w, rwkv_ln_b,
              rwkv_v0, rwkv_v_down, rwkv_v_up):
    lb_cum = jnp.cumsum(jax.nn.softmax(hgrn_lb_logits.astype(jnp.float32), axis=0), axis=0)
    lower_bounds = lb_cum - lb_cum[0]
    v_first = None
    h = x
    for l in range(DEPTH):
        u = rms_norm(h, norm_pre_mix[l])
        p = (u @ w_in[l]).astype(jnp.float32)
        p_ret, p_hgrn, p_ml, p_rw = split_cols(p, GROUP_COLS)
        o_ret = retention_group(p_ret)
        o_hgrn = hgrn2_group(p_hgrn, lower_bounds[l], hgrn_norm_w[l])
        o_ml = mlstm_group(p_ml, mlstm_conv_w[l], mlstm_conv_b[l], mlstm_i_bias[l],
                           mlstm_f_bias[l], mlstm_norm_w[l])
        vmix = None if l == 0 else (rwkv_v0[l - 1], rwkv_v_down[l - 1], rwkv_v_up[l - 1])
        o_rw, v_first = rwkv7_group(p_rw, v_first, rwkv_mu[l], rwkv_w0[l], rwkv_w_up[l],
                                    rwkv_a0[l], rwkv_a_up[l], rwkv_g_up[l], rwkv_k_k[l],
                                    rwkv_k_a[l], rwkv_r_k[l], rwkv_ln_w[l], rwkv_ln_b[l], vmix)
        mixed = jnp.concatenate([o_ret, o_hgrn, o_ml, o_rw], axis=-1).astype(h.dtype) @ w_out[l]
        h = h + rms_norm(mixed, norm_post_mix[l])
        u = rms_norm(h, norm_pre_ffn[l])
        ffn = (jax.nn.silu(u @ w_ffn_gate[l]) * (u @ w_ffn_up[l])) @ w_ffn_down[l]
        h = h + rms_norm(ffn, norm_post_ffn[l])
    return h
```

```cpp
#ifndef HOST_EMU
#include <hip/hip_runtime.h>
#include <cstdio>
#include <cstdint>
#endif

#ifndef BATCH
#define BATCH 16
#endif
#ifndef SEQ
#define SEQ 2048
#endif
constexpr int kB = BATCH, kS = SEQ, kM = kB * kS, kD = 2048, kL = 4, kG = 512, kH = 8, kHD = 64, kFF = 5632;
constexpr int kNIN = 7952, kNP = 8192;
constexpr int PC_RET = 0, PC_HG = 2048, PC_ML = 4096, PC_RW = 6144, PC_MLG = 7936;
constexpr int kRWS = 3584;
constexpr int RS_R = 0, RS_W = 512, RS_K = 1024, RS_V = 1536, RS_KK = 2048, RS_B = 2560, RS_G = 3072;
constexpr float kNormEps = 1e-6f, kRwkvLnEps = 64e-5f, kDecayScale = 0.6065306597126334f;

typedef unsigned short u16;
typedef short bf16x8 __attribute__((ext_vector_type(8)));
typedef float f32x4 __attribute__((ext_vector_type(4)));
typedef unsigned u32x4 __attribute__((ext_vector_type(4)));
typedef unsigned u32x2 __attribute__((ext_vector_type(2)));

#ifndef HOST_EMU
#define DEV __device__ __forceinline__
#define MDEV __device__ __forceinline__
#define LAS __attribute__((address_space(3)))
DEV f32x4 mfma16(bf16x8 a, bf16x8 b, f32x4 c) { return __builtin_amdgcn_mfma_f32_16x16x32_bf16(a, b, c, 0, 0, 0); }
template <int CTRL> DEV float dppf(float x) { return __builtin_bit_cast(float, __builtin_amdgcn_mov_dpp(__builtin_bit_cast(int, x), CTRL, 0xf, 0xf, true)); }
DEV float lx1(float x) { return dppf<0xB1>(x); }
DEV float lx2(float x) { return dppf<0x4E>(x); }
DEV float lm8(float x) { return dppf<0x141>(x); }
DEV float lr8(float x) { return dppf<0x128>(x); }
template <int CTRL, int RM> DEV float dppz(float x) { return __builtin_bit_cast(float, __builtin_amdgcn_update_dpp(0, __builtin_bit_cast(int, x), CTRL, RM, 0xf, true)); }
DEV float scan32(float v) { v += dppz<0x111, 0xf>(v); v += dppz<0x112, 0xf>(v); v += dppz<0x114, 0xf>(v); v += dppz<0x118, 0xf>(v); v += dppz<0x142, 0xa>(v); return v; }
DEV float xswap32(float x, bool lower) { auto t = __builtin_amdgcn_permlane32_swap(__builtin_bit_cast(unsigned, x), __builtin_bit_cast(unsigned, x), false, false); return __builtin_bit_cast(float, lower ? t[1] : t[0]); }
DEV float lxany(float x, int lane, int m) { return __builtin_bit_cast(float, __builtin_amdgcn_ds_bpermute((lane ^ m) << 2, __builtin_bit_cast(int, x))); }
DEV float rdlane(float x, int i) { return __builtin_bit_cast(float, __builtin_amdgcn_readlane(__builtin_bit_cast(int, x), i)); }
DEV void wave_sync() { asm volatile("s_waitcnt lgkmcnt(0)" ::: "memory"); __builtin_amdgcn_wave_barrier(); }
DEV void wait_vm0() { asm volatile("s_waitcnt vmcnt(0)" ::: "memory"); }
DEV void lds_sync() { asm volatile("s_waitcnt lgkmcnt(0)" ::: "memory"); __builtin_amdgcn_s_barrier(); }
DEV void glds16(const u16* g, LAS u16* lbase, int) { __builtin_amdgcn_global_load_lds((const unsigned*)g, (LAS unsigned*)lbase, 16, 0, 2); }
typedef float f32x2_ __attribute__((ext_vector_type(2)));
typedef __bf16 bf16x2_ __attribute__((ext_vector_type(2)));
DEV unsigned cvtpk(float lo, float hi) { const f32x2_ v = {lo, hi}; return __builtin_bit_cast(unsigned, __builtin_convertvector(v, bf16x2_)); }
DEV float fexp(float x) { return __expf(x); }
DEV float frcp(float x) { return __builtin_amdgcn_rcpf(x); }
DEV float frsq(float x) { return __builtin_amdgcn_rsqf(x); }
DEV float sin_rev(float fr) { return __builtin_amdgcn_sinf(fr); }
DEV float cos_rev(float fr) { return __builtin_amdgcn_cosf(fr); }
#endif

DEV float sum8(float x) { x += lx1(x); x += lx2(x); x += lm8(x); return x; }
DEV float sum16(float x) { x = sum8(x); x += lr8(x); return x; }
DEV float sum64(float v) { const float r = sum16(v); return (rdlane(r, 0) + rdlane(r, 16)) + (rdlane(r, 32) + rdlane(r, 48)); }

DEV u16 f2bf(float f) { unsigned u = __builtin_bit_cast(unsigned, f); return (u16)((u + 0x7fffu + ((u >> 16) & 1u)) >> 16); }
DEV float bf2f(u16 b) { return __builtin_bit_cast(float, ((unsigned)b) << 16); }
DEV unsigned pk2(float lo, float hi) { return (unsigned)f2bf(lo) | ((unsigned)f2bf(hi) << 16); }
DEV float sigm(float x) { return 1.0f / (1.0f + expf(-x)); }
DEV float fsig(float x) { return frcp(1.0f + fexp(-x)); }
DEV float logsig(float x) { return fminf(x, 0.f) - log1pf(expf(-fabsf(x))); }
DEV void unpack8(u32x4 v, float* o) {
    o[0] = bf2f((u16)(v.x & 0xffff)); o[1] = bf2f((u16)(v.x >> 16)); o[2] = bf2f((u16)(v.y & 0xffff)); o[3] = bf2f((u16)(v.y >> 16));
    o[4] = bf2f((u16)(v.z & 0xffff)); o[5] = bf2f((u16)(v.z >> 16)); o[6] = bf2f((u16)(v.w & 0xffff)); o[7] = bf2f((u16)(v.w >> 16));
}
DEV u32x4 pack8(const float* o) { u32x4 v; v.x = pk2(o[0], o[1]); v.y = pk2(o[2], o[3]); v.z = pk2(o[4], o[5]); v.w = pk2(o[6], o[7]); return v; }

constexpr size_t MiB = 1u << 20;
constexpr size_t al1m(size_t x) { return (x + MiB - 1) / MiB * MiB; }
constexpr size_t WS_CTL = 0, CTL_ZERO_BYTES = 1 * MiB;
constexpr size_t WS_TRIG = 1 * MiB;
constexpr size_t WS_R2 = 1 * MiB + 512 * 1024;
constexpr size_t WS_SW = 2 * MiB;
constexpr int SW_WUP = 0, SW_AUP = 512 * 64, SW_GUP = 2 * 512 * 64, SW_VDN = SW_GUP + 512 * 128, SW_VUP = SW_VDN + 32 * 512, SW_LAYER = SW_VUP + 512 * 32;
constexpr size_t WS_W = 4 * MiB;
constexpr size_t WO_IN = 0, WO_OUT = (size_t)kNP * kD * 2, WO_GU = WO_OUT + (size_t)kD * kD * 2, WO_DN = WO_GU + (size_t)2 * kFF * kD * 2, WO_END = WO_DN + (size_t)kD * kFF * 2;
constexpr size_t WS_U = WS_W + al1m(WO_END);
constexpr size_t WS_P = WS_U + al1m((size_t)kM * kD * 2);
constexpr size_t WS_Y = WS_P + al1m((size_t)kM * kNP * 2);
constexpr size_t WS_VF = WS_Y + al1m((size_t)kM * kRWS * 2);
constexpr size_t WS_END = WS_VF + al1m((size_t)kM * kG * 2);

struct Args { const float* in[31]; float* out; unsigned char* ws; int ph_lo, ph_hi; };
#ifndef HOST_EMU
typedef const __attribute__((address_space(4))) Args* KArgs;
DEV KArgs ka_fresh() { KArgs p = (KArgs)__builtin_amdgcn_kernarg_segment_ptr(); asm volatile("" : "+s"(p)); return p; }
#else
typedef const Args* KArgs;
#endif
struct Frame {
    LAS unsigned char* lds;
    int tid, lane, wave, G, bid;
    KArgs ka;
    MDEV const float* in(int i) const { return ka->in[i]; }
    MDEV float* out() const { return ka->out; }
    MDEV unsigned char* ws() const { return ka->ws; }
    MDEV u16* HB() const { return (u16*)(ws() + WS_U); }
    MDEV u16* O() const { return (u16*)out(); }
    MDEV float* R2() const { return (float*)(ws() + WS_R2); }
    MDEV u16* P() const { return (u16*)(ws() + WS_P); }
    MDEV u16* Y() const { return (u16*)(ws() + WS_Y); }
    MDEV u16* RWS() const { return (u16*)(ws() + WS_Y); }
    MDEV u16* VF() const { return (u16*)(ws() + WS_VF); }
    MDEV unsigned char* wbase(int l) const { return (l & 1) ? ws() + WS_W : (unsigned char*)out() + (size_t)kM * kD * 2; }
    MDEV u16* WinT(int l) const { return (u16*)(wbase(l) + WO_IN); }
    MDEV u16* WoutT(int l) const { return (u16*)(wbase(l) + WO_OUT); }
    MDEV u16* WguT(int l) const { return (u16*)(wbase(l) + WO_GU); }
    MDEV u16* WdT(int l) const { return (u16*)(wbase(l) + WO_DN); }
    MDEV u16* SW() const { return (u16*)(ws() + WS_SW); }
    MDEV float* TRIG() const { return (float*)(ws() + WS_TRIG); }
};
enum { I_X = 0, I_WIN, I_WOUT, I_NPM, I_NQM, I_NPF, I_NQF, I_WG, I_WU, I_WD, I_HLB, I_HNW, I_MCW, I_MCB, I_MIB, I_MFB, I_MNW, I_MU, I_W0, I_WUP, I_A0, I_AUP, I_GUP, I_KK, I_KA, I_RK, I_LNW, I_LNB, I_V0, I_VDN, I_VUP };

DEV void init_phase(Frame& F) {
    const int gt = F.bid * 512 + F.tid, NT = F.G * 512;
    for (int i = gt; i < kS * 32; i += NT) {
        const int pos = i >> 5, j = i & 31;
        const float invf = powf(10000.0f, -(float)j / 32.0f);
        const float ang = (float)pos * invf;
        const double rev = (double)ang * 0.15915494309189535;
        const float fr = (float)(rev - floor(rev));
        F.TRIG()[2 * i] = cos_rev(fr); F.TRIG()[2 * i + 1] = sin_rev(fr);
    }
    for (int i = gt; i < kL * SW_LAYER; i += NT) {
        const int l = i / SW_LAYER, r = i % SW_LAYER; float v;
        if (r < SW_AUP) { const int n = r / 64, k = r % 64; v = F.in(I_WUP)[((size_t)l * 64 + k) * 512 + n]; }
        else if (r < SW_GUP) { const int q = r - SW_AUP, n = q / 64, k = q % 64; v = F.in(I_AUP)[((size_t)l * 64 + k) * 512 + n]; }
        else if (r < SW_VDN) { const int q = r - SW_GUP, n = q / 128, k = q % 128; v = F.in(I_GUP)[((size_t)l * 128 + k) * 512 + n]; }
        else if (r < SW_VUP) { const int q = r - SW_VDN, n = q / 512, k = q % 512; v = l > 0 ? F.in(I_VDN)[((size_t)(l - 1) * 512 + k) * 32 + n] : 0.f; }
        else { const int q = r - SW_VUP, n = q / 32, k = q % 32; v = l > 0 ? F.in(I_VUP)[((size_t)(l - 1) * 32 + k) * 512 + n] : 0.f; }
        F.SW()[i] = f2bf(v);
    }
}

DEV void conv_item(Frame& F, int l, int mat, int nb, int kb) {
    LAS float* tile = (LAS float*)F.lds;
    const int nn = F.tid & 63, k8 = F.tid >> 6;
    const int n = nb * 64 + nn;
    const float* src; int ld, sc; bool ok = true; int K; const float* gk = nullptr;
    if (mat == 0) { K = kD; ld = kNIN; src = F.in(I_WIN) + (size_t)l * kD * kNIN; gk = F.in(I_NPM) + l * kD;
        if (n < PC_RW) sc = n; else if (n < PC_MLG) sc = n + 16; else if (n < PC_MLG + 16) sc = n - PC_MLG + 6144; else { sc = 0; ok = false; } }
    else if (mat == 1) { K = kD; ld = kD; src = F.in(I_WOUT) + (size_t)l * kD * kD; sc = n; }
    else if (mat == 2) { K = kD; ld = kFF; gk = F.in(I_NPF) + l * kD; const int pn = n >> 8, w = n & 255; src = (w < 128 ? F.in(I_WG) : F.in(I_WU)) + (size_t)l * kD * kFF; sc = pn * 128 + (w & 127); }
    else { K = kFF; ld = kD; src = F.in(I_WD) + (size_t)l * kFF * kD; sc = n; }
#pragma unroll
    for (int i = 0; i < 8; ++i) { const int kk = k8 + 8 * i; float v = ok ? __builtin_nontemporal_load(src + (size_t)(kb * 64 + kk) * ld + sc) : 0.f; if (gk) v *= gk[kb * 64 + kk]; tile[kk * 65 + nn] = v; }
    __syncthreads();
    u16* dst = mat == 0 ? F.WinT(l) : mat == 1 ? F.WoutT(l) : mat == 2 ? F.WguT(l) : F.WdT(l);
    const int rn = F.tid >> 3, kc = F.tid & 7;
    float o[8];
#pragma unroll
    for (int j = 0; j < 8; ++j) o[j] = tile[(8 * kc + j) * 65 + rn];
    *(u32x4*)(dst + (size_t)(nb * 64 + rn) * K + kb * 64 + 8 * kc) = pack8(o);
    __syncthreads();
}
DEV void conv_phase(Frame& F, int l, bool first_only) {
    constexpr int KB2 = kD / 64, KB3 = kFF / 64;
    constexpr int N0 = (kNP / 64) * KB2, N1 = (kD / 64) * KB2, N2 = (2 * kFF / 64) * KB2, N3 = (kD / 64) * KB3;
    for (int it = F.bid; it < N0 + N1 + (first_only ? 0 : N2 + N3); it += F.G) {
        int r = it;
        if (r < N0) { conv_item(F, l, 0, r / KB2, r % KB2); continue; } r -= N0;
        if (r < N1) { conv_item(F, l, 1, r / KB2, r % KB2); continue; } r -= N1;
        if (r < N2) { conv_item(F, l, 2, r / KB2, r % KB2); continue; } r -= N2;
        conv_item(F, l, 3, r / KB3, r % KB3);
    }
}


constexpr int CV_KB2 = kD / 64, CV_KB3 = kFF / 64;
constexpr int CV_N0 = (kNP / 64) * CV_KB2, CV_N1 = (kD / 64) * CV_KB2, CV_N2 = (2 * kFF / 64) * CV_KB2, CV_N3 = (kD / 64) * CV_KB3, CV_NT = CV_N0 + CV_N1 + CV_N2 + CV_N3;
DEV void conv_wave_tile(Frame& F, int l, int it, int lane) {
    int mat, nb, kb; int r = it;
    if (r < CV_N0) { mat = 0; nb = r / CV_KB2; kb = r % CV_KB2; } else { r -= CV_N0;
    if (r < CV_N1) { mat = 1; nb = r / CV_KB2; kb = r % CV_KB2; } else { r -= CV_N1;
    if (r < CV_N2) { mat = 2; nb = r / CV_KB2; kb = r % CV_KB2; } else { r -= CV_N2; mat = 3; nb = r / CV_KB3; kb = r % CV_KB3; } } }
    const int n = nb * 64 + lane;
    const float* src; int ld, sc; bool ok = true; int K; const float* gk = nullptr; u16* dst;
    if (mat == 0) { K = kD; ld = kNIN; src = F.in(I_WIN) + (size_t)l * kD * kNIN; gk = F.in(I_NPM) + l * kD; dst = F.WinT(l);
        if (n < PC_RW) sc = n; else if (n < PC_MLG) sc = n + 16; else if (n < PC_MLG + 16) sc = n - PC_MLG + 6144; else { sc = 0; ok = false; } }
    else if (mat == 1) { K = kD; ld = kD; src = F.in(I_WOUT) + (size_t)l * kD * kD; sc = n; dst = F.WoutT(l); }
    else if (mat == 2) { K = kD; ld = kFF; gk = F.in(I_NPF) + l * kD; const int pn = n >> 8, w = n & 255; src = (w < 128 ? F.in(I_WG) : F.in(I_WU)) + (size_t)l * kD * kFF; sc = pn * 128 + (w & 127); dst = F.WguT(l); }
    else { K = kFF; ld = kD; src = F.in(I_WD) + (size_t)l * kFF * kD; sc = n; dst = F.WdT(l); }
    const float* sp = src + (size_t)(kb * 64) * ld + sc;
#pragma unroll 1
    for (int half = 0; half < 2; ++half) {
        float v[32];
#pragma unroll
        for (int i = 0; i < 32; ++i) v[i] = ok ? __builtin_nontemporal_load(sp + (size_t)(32 * half + i) * ld) : 0.f;
        if (gk) {
#pragma unroll
            for (int i = 0; i < 32; ++i) v[i] *= gk[kb * 64 + 32 * half + i]; }
#pragma unroll
        for (int g = 0; g < 4; ++g) { u32x4 o; o.x = cvtpk(v[8 * g], v[8 * g + 1]); o.y = cvtpk(v[8 * g + 2], v[8 * g + 3]); o.z = cvtpk(v[8 * g + 4], v[8 * g + 5]); o.w = cvtpk(v[8 * g + 6], v[8 * g + 7]);
            *(u32x4*)(dst + (size_t)n * K + kb * 64 + 32 * half + 8 * g) = o; }
    }
}

template <int MODE, bool DUMMY = false> DEV void norm_phase(Frame& F, const float* gy, int wpg = 8) {
    if (F.wave >= wpg) return;
    const int gw = F.bid * wpg + F.wave, NW = F.G * wpg;
    u32x4 yq[4], hq[4];
    if (MODE != 0 && gw < kM) {
#pragma unroll
        for (int j = 0; j < 4; ++j) { yq[j] = __builtin_nontemporal_load((const u32x4*)(F.Y() + (size_t)gw * kD + 8 * (F.lane + 64 * j))); hq[j] = *(const u32x4*)(F.HB() + (size_t)gw * kD + 8 * (F.lane + 64 * j)); }
    }
    for (int m = gw; m < kM; m += NW) {
        float h[32];
        u16* hb = F.HB() + (size_t)m * kD;
        if (MODE == 0) {
            const float* xrow = F.in(I_X) + (size_t)m * kD;
#pragma unroll
            for (int j = 0; j < 4; ++j) { const int e = 8 * (F.lane + 64 * j);
                const f32x4 a = __builtin_nontemporal_load((const f32x4*)(xrow + e)), b = __builtin_nontemporal_load((const f32x4*)(xrow + e + 4));
                h[8 * j + 0] = a.x; h[8 * j + 1] = a.y; h[8 * j + 2] = a.z; h[8 * j + 3] = a.w; h[8 * j + 4] = b.x; h[8 * j + 5] = b.y; h[8 * j + 6] = b.z; h[8 * j + 7] = b.w; }
        } else {
            float y[32]; float ss = 0.f;
#pragma unroll
            for (int j = 0; j < 4; ++j) { unpack8(yq[j], y + 8 * j); unpack8(hq[j], h + 8 * j); }
            if (m + NW < kM) {
#pragma unroll
                for (int j = 0; j < 4; ++j) { yq[j] = __builtin_nontemporal_load((const u32x4*)(F.Y() + (size_t)(m + NW) * kD + 8 * (F.lane + 64 * j))); hq[j] = *(const u32x4*)(F.HB() + (size_t)(m + NW) * kD + 8 * (F.lane + 64 * j)); }
            }
#pragma unroll
            for (int i = 0; i < 32; ++i) ss += y[i] * y[i];
            const float r = 1.0f / sqrtf(sum64(ss) * (1.0f / kD) + kNormEps);
#pragma unroll
            for (int j = 0; j < 4; ++j) { const int e = 8 * (F.lane + 64 * j);
#pragma unroll
                for (int i = 0; i < 8; ++i) h[8 * j + i] += y[8 * j + i] * r * gy[e + i]; }
        }
        if (MODE == 2) {
            float* orow = F.out() + (size_t)m * kD;
#pragma unroll
            for (int j = 0; j < 4; ++j) { const int e = 8 * (F.lane + 64 * j);
                *(f32x4*)(orow + e) = (f32x4){h[8 * j], h[8 * j + 1], h[8 * j + 2], h[8 * j + 3]};
                *(f32x4*)(orow + e + 4) = (f32x4){h[8 * j + 4], h[8 * j + 5], h[8 * j + 6], h[8 * j + 7]}; }
        } else {
            float ss = 0.f;
#pragma unroll
            for (int i = 0; i < 32; ++i) ss += h[i] * h[i];
            const float r2 = 1.0f / sqrtf(sum64(ss) * (1.0f / kD) + kNormEps);
            if (F.lane == 0) F.R2()[m] = r2;
#pragma unroll
            for (int j = 0; j < 4; ++j) *(u32x4*)(hb + 8 * (F.lane + 64 * j)) = pack8(h + 8 * j);
        }
    }
}

constexpr int PL_KX = 0, PL_VX = 16 * 520 * 2, PL_A1 = 2 * 16 * 520 * 2, PL_A2 = PL_A1 + 16 * 72 * 2, PL_A3 = PL_A2 + 16 * 72 * 2, PL_T1 = PL_A3 + 16 * 136 * 2, PL_MU = PL_T1 + 16 * 40 * 2, PL_OT = PL_MU + 1792 * 4, PL_RAW = (PL_OT + 8 * 1536 + 1023) / 1024 * 1024, PL_END = PL_RAW + 65536;
static_assert(PL_RAW % 1024 == 0, "raw tile alignment");
DEV bf16x8 ldsfrag(const LAS u16* base, int stride, int row, int k) { return *(const LAS bf16x8*)(base + row * stride + k); }
DEV bf16x8 glbfrag(const u16* base, int stride, int row, int k) { return *(const bf16x8*)(base + (size_t)row * stride + k); }

DEV void prep_phase(Frame& F, int l) {
    LAS u16* KX = (LAS u16*)(F.lds + PL_KX); LAS u16* VX = (LAS u16*)(F.lds + PL_VX);
    LAS u16* A1 = (LAS u16*)(F.lds + PL_A1); LAS u16* A2 = (LAS u16*)(F.lds + PL_A2); LAS u16* A3 = (LAS u16*)(F.lds + PL_A3); LAS u16* T1 = (LAS u16*)(F.lds + PL_T1);
    LAS float* MU = (LAS float*)(F.lds + PL_MU); LAS float* PT = (LAS float*)(F.lds + PL_OT + F.wave * 1536);
    LAS u16* RAW = (LAS u16*)(F.lds + PL_RAW);
    for (int i = F.tid; i < 1792; i += 512) MU[i] = F.in(I_MU)[(size_t)l * 1792 + i];
    { const int ch = 64 * F.wave + F.lane; PT[F.lane] = F.in(I_W0)[l * 512 + ch]; PT[64 + F.lane] = F.in(I_A0)[l * 512 + ch]; PT[128 + F.lane] = F.in(I_KK)[l * 512 + ch]; PT[192 + F.lane] = F.in(I_KA)[l * 512 + ch];
      PT[256 + F.lane] = l > 0 ? F.in(I_V0)[(l - 1) * 512 + ch] : 0.f; }
    __syncthreads();
    const u16* sw = F.SW() + (size_t)l * SW_LAYER;
    const int w = F.wave, c = F.lane & 15, q = F.lane >> 4;
    bf16x8 wfr[4][2], afr[4][2];
#pragma unroll
    for (int tn = 0; tn < 4; ++tn)
#pragma unroll
        for (int ks = 0; ks < 2; ++ks) { wfr[tn][ks] = glbfrag(sw + SW_WUP, 64, 64 * w + 16 * tn + c, 32 * ks + 8 * q); afr[tn][ks] = glbfrag(sw + SW_AUP, 64, 64 * w + 16 * tn + c, 32 * ks + 8 * q); }
#define PREP_DMA(it_) do { const int tk_ = (it_) * 16; const bool first_ = (tk_ % kS) == 0; _Pragma("unroll") for (int j_ = 0; j_ < 8; ++j_) { int p_ = 512 * w + 64 * j_ + F.lane; if (p_ >= 17 * 224) p_ = 0; \
        const int r_ = p_ / 224, g_ = p_ % 224; const int tok_ = tk_ - 1 + r_ + ((first_ && r_ == 0) ? 1 : 0); \
        glds16(F.P() + (size_t)tok_ * kNP + PC_RW + 8 * g_, RAW + (512 * w + 64 * j_) * 8, F.lane); } } while (0)
    if (F.bid < kM / 16) PREP_DMA(F.bid);
    for (int item = F.bid; item < kM / 16; item += F.G) {
        const int tk0 = item * 16;
        wait_vm0(); __syncthreads();
#define PREP_MIX(row_, col_) float xs[8]; { float cur[8], prv[8]; const u32x4 cq = *(const LAS u32x4*)(RAW + ((row_) + 1) * 1792 + (col_)); u32x4 pq = *(const LAS u32x4*)(RAW + (row_) * 1792 + (col_)); \
            if (((tk0 + (row_)) % kS) == 0) pq = (u32x4){0u, 0u, 0u, 0u}; \
            unpack8(cq, cur); unpack8(pq, prv); const f32x4 m0 = *(const LAS f32x4*)(MU + (col_)), m1 = *(const LAS f32x4*)(MU + (col_) + 4); \
            xs[0] = cur[0] + (prv[0] - cur[0]) * m0.x; xs[1] = cur[1] + (prv[1] - cur[1]) * m0.y; xs[2] = cur[2] + (prv[2] - cur[2]) * m0.z; xs[3] = cur[3] + (prv[3] - cur[3]) * m0.w; \
            xs[4] = cur[4] + (prv[4] - cur[4]) * m1.x; xs[5] = cur[5] + (prv[5] - cur[5]) * m1.y; xs[6] = cur[6] + (prv[6] - cur[6]) * m1.z; xs[7] = cur[7] + (prv[7] - cur[7]) * m1.w; }
#pragma unroll 1
        for (int i = 0; i < 6; ++i) { const int idx = F.tid + 512 * i; const int row = idx / 192, col = 8 * (idx % 192);
            PREP_MIX(row, col);
            if (col < 512) { *(u32x4*)(F.RWS() + (size_t)(tk0 + row) * kRWS + RS_R + col) = pack8(xs); }
            else if (col < 1024) { *(LAS u32x4*)(KX + row * 520 + (col - 512)) = pack8(xs); }
            else { *(LAS u32x4*)(VX + row * 520 + (col - 1024)) = pack8(xs); } }
        int lt_ = F.tid;
#ifndef HOST_EMU
        asm volatile("" : "+v"(lt_));
#endif
        if (w < 2) { const int p = lt_, row = p >> 3, cg = 8 * (p & 7);
            PREP_MIX(row, 1536 + cg);
#pragma unroll
            for (int e = 0; e < 8; ++e) { const float t = fexp(2.0f * xs[e]); xs[e] = 1.0f - 2.0f * frcp(t + 1.0f); }
            *(LAS u32x4*)(A1 + row * 72 + cg) = pack8(xs); }
        else if (w < 4) { const int p = lt_ - 128, row = p >> 3, cg = 8 * (p & 7);
            PREP_MIX(row, 1600 + cg);
            *(LAS u32x4*)(A2 + row * 72 + cg) = pack8(xs); }
        else { const int p = lt_ - 256, row = p >> 4, cg = 8 * (p & 15);
            PREP_MIX(row, 1664 + cg);
#pragma unroll
            for (int e = 0; e < 8; ++e) xs[e] = fsig(xs[e]);
            *(LAS u32x4*)(A3 + row * 136 + cg) = pack8(xs); }
#undef PREP_MIX
        __syncthreads();
        if (item + F.G < kM / 16) PREP_DMA(item + F.G);
        bf16x8 gfr[4][4];
#pragma unroll
        for (int tn = 0; tn < 4; ++tn) {
#pragma unroll
            for (int ks = 0; ks < 4; ++ks) gfr[tn][ks] = glbfrag(sw + SW_GUP, 128, 64 * w + 16 * tn + c, 32 * ks + 8 * q); }
        if (l > 0) {
            if (w < 2) { const int tn = w; f32x4 acc = {0.f, 0.f, 0.f, 0.f}; bf16x8 dn[16];
#pragma unroll
                for (int ks = 0; ks < 16; ++ks) dn[ks] = glbfrag(sw + SW_VDN, 512, 16 * tn + c, 32 * ks + 8 * q);
#pragma unroll
                for (int ks = 0; ks < 16; ++ks) acc = mfma16(ldsfrag(VX, 520, c, 32 * ks + 8 * q), dn[ks], acc);
#pragma unroll
                for (int j = 0; j < 4; ++j) T1[(4 * q + j) * 40 + 16 * tn + c] = f2bf(acc[j]); }
            __syncthreads();
        }
        {
            const int trow = c;
            int pto = 4 * q;
#ifndef HOST_EMU
            asm volatile("" : "+v"(pto));
#endif
            const LAS float* PTq = PT + pto;
            u16* orow = F.RWS() + (size_t)(tk0 + trow) * kRWS + 64 * w + 4 * q;
#pragma unroll
            for (int tn = 0; tn < 4; ++tn) { f32x4 acc = {0.f, 0.f, 0.f, 0.f};
#pragma unroll
                for (int ks = 0; ks < 4; ++ks) acc = mfma16(gfr[tn][ks], ldsfrag(A3, 136, trow, 32 * ks + 8 * q), acc);
                u32x2 o; o.x = cvtpk(acc[0], acc[1]); o.y = cvtpk(acc[2], acc[3]);
                *(u32x2*)(orow + RS_G + 16 * tn) = o; }
            bf16x8 vfr[4]; u32x2 vfq[4];
#pragma unroll
            for (int tn = 0; tn < 4; ++tn) vfr[tn] = glbfrag(sw + SW_VUP, 32, 64 * w + 16 * tn + c, 8 * q);
            if (l > 0) {
#pragma unroll
                for (int tn = 0; tn < 4; ++tn) vfq[tn] = *(const u32x2*)(F.VF() + (size_t)(tk0 + trow) * kG + 64 * w + 16 * tn + 4 * q); }
            const bf16x8 x10 = ldsfrag(A1, 72, trow, 8 * q), x11 = ldsfrag(A1, 72, trow, 32 + 8 * q), x20 = ldsfrag(A2, 72, trow, 8 * q), x21 = ldsfrag(A2, 72, trow, 32 + 8 * q);
#pragma unroll
            for (int tn = 0; tn < 4; ++tn) { f32x4 acc = {0.f, 0.f, 0.f, 0.f};
                acc = mfma16(wfr[tn][0], x10, acc); acc = mfma16(wfr[tn][1], x11, acc);
                const f32x4 w0v = *(const LAS f32x4*)(PTq + 16 * tn);
                u32x2 o; o.x = cvtpk(fexp(-kDecayScale * fsig(w0v.x + acc[0])), fexp(-kDecayScale * fsig(w0v.y + acc[1]))); o.y = cvtpk(fexp(-kDecayScale * fsig(w0v.z + acc[2])), fexp(-kDecayScale * fsig(w0v.w + acc[3])));
                *(u32x2*)(orow + RS_W + 16 * tn) = o; }
            f32x4 av[4]; float ss = 0.f;
#pragma unroll
            for (int tn = 0; tn < 4; ++tn) { f32x4 acc = {0.f, 0.f, 0.f, 0.f};
                acc = mfma16(afr[tn][0], x20, acc); acc = mfma16(afr[tn][1], x21, acc);
                const f32x4 a0v = *(const LAS f32x4*)(PTq + 64 + 16 * tn), kkv = *(const LAS f32x4*)(PTq + 128 + 16 * tn);
                const u32x2 kb = *(const LAS u32x2*)(KX + trow * 520 + 64 * w + 16 * tn + 4 * q);
                const f32x4 kf = {bf2f((u16)(kb.x & 0xffffu)), bf2f((u16)(kb.x >> 16)), bf2f((u16)(kb.y & 0xffffu)), bf2f((u16)(kb.y >> 16))};
                av[tn] = (f32x4){fsig(a0v.x + acc[0]), fsig(a0v.y + acc[1]), fsig(a0v.z + acc[2]), fsig(a0v.w + acc[3])};
                const f32x4 kr = kf * kkv; ss += (kr.x * kr.x + kr.y * kr.y) + (kr.z * kr.z + kr.w * kr.w); }
            ss += lxany(ss, F.lane, 16); ss += lxany(ss, F.lane, 32);
            const float inv = 1.0f / fmaxf(sqrtf(ss), 1e-12f);
#pragma unroll
            for (int tn = 0; tn < 4; ++tn) {
                const f32x4 kkv = *(const LAS f32x4*)(PTq + 128 + 16 * tn), kav = *(const LAS f32x4*)(PTq + 192 + 16 * tn);
                const u32x2 kb = *(const LAS u32x2*)(KX + trow * 520 + 64 * w + 16 * tn + 4 * q);
                const f32x4 kf = {bf2f((u16)(kb.x & 0xffffu)), bf2f((u16)(kb.x >> 16)), bf2f((u16)(kb.y & 0xffffu)), bf2f((u16)(kb.y >> 16))};
                const f32x4 a = av[tn], kkn = kf * kkv * inv, kp = kf * (1.0f + (a - 1.0f) * kav), bb = a * kkn;
                u32x2 o; o.x = cvtpk(kp.x, kp.y); o.y = cvtpk(kp.z, kp.w); *(u32x2*)(orow + RS_K + 16 * tn) = o;
                o.x = cvtpk(kkn.x, kkn.y); o.y = cvtpk(kkn.z, kkn.w); *(u32x2*)(orow + RS_KK + 16 * tn) = o;
                o.x = cvtpk(bb.x, bb.y); o.y = cvtpk(bb.z, bb.w); *(u32x2*)(orow + RS_B + 16 * tn) = o; }
            const bf16x8 t1f = ldsfrag(T1, 40, trow, 8 * q);
#pragma unroll
            for (int tn = 0; tn < 4; ++tn) {
                f32x4 acc = {0.f, 0.f, 0.f, 0.f};
                if (l > 0) acc = mfma16(vfr[tn], t1f, acc);
                const u32x2 vb = *(const LAS u32x2*)(VX + trow * 520 + 64 * w + 16 * tn + 4 * q);
                f32x4 vo = {bf2f((u16)(vb.x & 0xffffu)), bf2f((u16)(vb.x >> 16)), bf2f((u16)(vb.y & 0xffffu)), bf2f((u16)(vb.y >> 16))};
                if (l > 0) { const f32x4 v0v = *(const LAS f32x4*)(PTq + 256 + 16 * tn);
                    const f32x4 v1 = {bf2f((u16)(vfq[tn].x & 0xffffu)), bf2f((u16)(vfq[tn].x >> 16)), bf2f((u16)(vfq[tn].y & 0xffffu)), bf2f((u16)(vfq[tn].y >> 16))};
                    const f32x4 mix = {fsig(v0v.x + acc[0]), fsig(v0v.y + acc[1]), fsig(v0v.z + acc[2]), fsig(v0v.w + acc[3])};
                    vo = vo + (v1 - vo) * mix; }
                else *(u32x2*)(F.VF() + (size_t)(tk0 + trow) * kG + 64 * w + 16 * tn + 4 * q) = vb;
                u32x2 o; o.x = cvtpk(vo.x, vo.y); o.y = cvtpk(vo.z, vo.w); *(u32x2*)(orow + RS_V + 16 * tn) = o; }
        }
    }
#undef PREP_DMA
}

#ifndef RWKV_SCAN_MFMA
#define RWKV_SCAN_MFMA 1
#endif
constexpr int SL_TB = 32, SL_TS = SL_TB * 64;
constexpr int SL_BUF = 7 * SL_TS * 4;
constexpr int SL_Y = 2 * SL_BUF, SL_U = SL_Y + 2 * SL_TS * 4, SL_END = SL_U + 2 * (SL_TB / 2) * 256 * 2;
DEV float dot4(f32x4 a, f32x4 b) { return (a.x * b.x + a.y * b.y) + (a.z * b.z + a.w * b.w); }
DEV void rwkv_scan(Frame& F, int l, int b, int hh) {
    constexpr int TB = SL_TB, TS = SL_TS, NB = kS / TB;
    int tid_ = F.tid;
#ifndef HOST_EMU
    asm volatile("" : "+v"(tid_));
#endif
    const int xtid = tid_, xlane = tid_ & 63;
    const int mq = xlane >> 4, mi0 = 16 * (F.wave & 3) + (xlane & 15);
    f32x4 SA0 = {0.f, 0.f, 0.f, 0.f}, SA1 = SA0, SB0 = SA0, SB1 = SA0; bf16x8 sA = {0, 0, 0, 0, 0, 0, 0, 0}, sB = sA;
    const int es = xtid & 15, ech = 64 * hh + 4 * es;
    const f32x4 lnw = *(const f32x4*)(F.in(I_LNW) + l * 512 + ech), lnb = *(const f32x4*)(F.in(I_LNB) + l * 512 + ech), rk = *(const f32x4*)(F.in(I_RK) + l * 512 + ech);
    const u16* rws = F.RWS() + (size_t)b * kS * kRWS + 64 * hh;
    const int hid = xtid - 256, hp = (hid >> 3) & 15, hg = hid & 7;
    u32x4 pre[14];
    const unsigned hoffb = (unsigned)((2 * hp) * kRWS + 8 * hg) * 2u;
#define RW_LOAD(blk_) do { const char* rb_ = (const char*)(rws + (size_t)(blk_) * TB * kRWS); _Pragma("unroll") for (int rr_ = 0; rr_ < 2; ++rr_) _Pragma("unroll") for (int tz_ = 0; tz_ < 7; ++tz_) \
        pre[7 * rr_ + tz_] = __builtin_nontemporal_load((const u32x4*)(rb_ + hoffb + (unsigned)((rr_ * kRWS + tz_ * 512) * 2))); } while (0)
#define PUT8(slot_, row_, v_) do { LAS float* d_ = LTn + (slot_) * TS + (row_) * 64 + 8 * hg; *(LAS f32x4*)d_ = (f32x4){(v_)[0], (v_)[1], (v_)[2], (v_)[3]}; *(LAS f32x4*)(d_ + 4) = (f32x4){(v_)[4], (v_)[5], (v_)[6], (v_)[7]}; } while (0)
#define PUTU(row_, v_) do { u32x4 o_; o_.x = cvtpk((v_)[0], (v_)[1]); o_.y = cvtpk((v_)[2], (v_)[3]); o_.z = cvtpk((v_)[4], (v_)[5]); o_.w = cvtpk((v_)[6], (v_)[7]); *(LAS u32x4*)(Un + hp * 256 + (row_) * 64 + 8 * hg) = o_; } while (0)
#define DOT8(a_, b_) ((((a_)[0] * (b_)[0] + (a_)[1] * (b_)[1]) + ((a_)[2] * (b_)[2] + (a_)[3] * (b_)[3])) + (((a_)[4] * (b_)[4] + (a_)[5] * (b_)[5]) + ((a_)[6] * (b_)[6] + (a_)[7] * (b_)[7])))
#define RW_STAGE(bi_) do { LAS float* LTn = (LAS float*)(F.lds + (bi_) * SL_BUF); LAS u16* Un = (LAS u16*)(F.lds + SL_U + (bi_) * (TB / 2) * 512); \
        float r1[8], w1[8], k1[8], x1[8], kk1[8], b1[8], r2[8], w2[8], k2[8], kk2[8], b2[8], t_[8], u_[8]; \
        unpack8(pre[0], r1); unpack8(pre[1], w1); unpack8(pre[2], k1); unpack8(pre[4], kk1); unpack8(pre[5], b1); \
        unpack8(pre[7], r2); unpack8(pre[8], w2); unpack8(pre[9], k2); unpack8(pre[11], kk2); unpack8(pre[12], b2); \
        PUT8(0, 2 * hp, r1); PUT8(0, 2 * hp + 1, r2); PUT8(2, 2 * hp, k1); PUT8(2, 2 * hp + 1, k2); PUT8(5, 2 * hp + 1, b2); \
        unpack8(pre[3], x1); PUT8(3, 2 * hp, x1); unpack8(pre[10], x1); PUT8(3, 2 * hp + 1, x1); unpack8(pre[6], x1); PUT8(6, 2 * hp, x1); unpack8(pre[13], x1); PUT8(6, 2 * hp + 1, x1); \
        PUTU(0, kk1); \
        const float c0 = sum8(DOT8(k1, kk2)), c1 = sum8(DOT8(b1, kk2)), c2 = sum8(DOT8(k1, r1)), c3 = sum8(DOT8(b1, r1)), c6 = sum8(DOT8(k2, r2)), c7 = sum8(DOT8(b2, r2)); \
        _Pragma("unroll") for (int e_ = 0; e_ < 8; ++e_) t_[e_] = w1[e_] * kk2[e_]; PUTU(1, t_); \
        _Pragma("unroll") for (int e_ = 0; e_ < 8; ++e_) t_[e_] = w1[e_] * r1[e_]; PUTU(2, t_); \
        _Pragma("unroll") for (int e_ = 0; e_ < 8; ++e_) u_[e_] = w1[e_] * w2[e_]; PUT8(1, 2 * hp, u_); \
        _Pragma("unroll") for (int e_ = 0; e_ < 8; ++e_) t_[e_] = u_[e_] * r2[e_]; PUTU(3, t_); \
        _Pragma("unroll") for (int e_ = 0; e_ < 8; ++e_) t_[e_] = k1[e_] * w2[e_]; PUT8(1, 2 * hp + 1, t_); const float c4 = sum8(DOT8(t_, r2)); \
        _Pragma("unroll") for (int e_ = 0; e_ < 8; ++e_) t_[e_] = b1[e_] * w2[e_]; PUT8(5, 2 * hp, t_); const float c5 = sum8(DOT8(t_, r2)); \
        if (hg == 0) { LAS float* d_ = LTn + 4 * TS + (2 * hp) * 64; *(LAS f32x4*)d_ = (f32x4){c0, c1, c2, c3}; *(LAS f32x4*)(d_ + 4) = (f32x4){c4, c5, c6, c7}; } } while (0)
    const bool helper = F.wave == 4 || F.wave == 5;
    if (helper) { RW_LOAD(0); RW_STAGE(0); if (NB > 1) RW_LOAD(1); }
    lds_sync();
    for (int blk = 0; blk < NB; ++blk) {
        const int bi = blk & 1; const size_t tok0 = (size_t)b * kS + (size_t)blk * TB;
        LAS float* LT = (LAS float*)(F.lds + bi * SL_BUF); LAS float* LY = (LAS float*)(F.lds + SL_Y + bi * TS * 4); LAS u16* LU = (LAS u16*)(F.lds + SL_U + bi * (TB / 2) * 512);
        if (F.wave < 4) {
#pragma unroll 2
        for (int pi = 0; pi < TB / 2; ++pi) {
            const f32x4 z4 = {0.f, 0.f, 0.f, 0.f};
            const LAS u16* uf = LU + pi * 256 + (xlane & 3) * 64 + 8 * mq;
            f32x4 acc = mfma16(*(const LAS bf16x8*)uf, sA, z4);
            acc = mfma16(*(const LAS bf16x8*)(uf + 32), sB, acc);
            const LAS float* base = LT + (2 * pi) * 64 + 8 * mq;
            const f32x4 wa0 = *(const LAS f32x4*)(base + TS), wa1 = *(const LAS f32x4*)(base + TS + 4), wb0 = *(const LAS f32x4*)(base + TS + 32), wb1 = *(const LAS f32x4*)(base + TS + 36);
            const f32x4 ka0 = *(const LAS f32x4*)(base + TS + 64), ka1 = *(const LAS f32x4*)(base + TS + 68), kb0 = *(const LAS f32x4*)(base + TS + 96), kb1 = *(const LAS f32x4*)(base + TS + 100);
            const f32x4 ba0 = *(const LAS f32x4*)(base + 5 * TS), ba1 = *(const LAS f32x4*)(base + 5 * TS + 4), bb0 = *(const LAS f32x4*)(base + 5 * TS + 32), bb1 = *(const LAS f32x4*)(base + 5 * TS + 36);
            const f32x4 kc0 = *(const LAS f32x4*)(base + 2 * TS + 64), kc1 = *(const LAS f32x4*)(base + 2 * TS + 68), kd0 = *(const LAS f32x4*)(base + 2 * TS + 96), kd1 = *(const LAS f32x4*)(base + 2 * TS + 100);
            const f32x4 bc0 = *(const LAS f32x4*)(base + 5 * TS + 64), bc1 = *(const LAS f32x4*)(base + 5 * TS + 68), bd0 = *(const LAS f32x4*)(base + 5 * TS + 96), bd1 = *(const LAS f32x4*)(base + 5 * TS + 100);
            const f32x4 s0 = *(const LAS f32x4*)(LT + 4 * TS + (2 * pi) * 64), s1 = *(const LAS f32x4*)(LT + 4 * TS + (2 * pi) * 64 + 4);
            const float v1 = LT[3 * TS + (2 * pi) * 64 + mi0], v2 = LT[3 * TS + (2 * pi + 1) * 64 + mi0];
            const float p1 = acc[0];
            const float p2 = (acc[1] + v1 * s0[0]) - p1 * s0[1];
            const float y1 = (acc[2] + v1 * s0[2]) - p1 * s0[3];
            const float y2 = ((acc[3] + v1 * s1[0]) - p1 * s1[1]) + (v2 * s1[2] - p2 * s1[3]);
            SA0 = ((SA0 * wa0 + ka0 * v1) - ba0 * p1) + (kc0 * v2 - bc0 * p2); SA1 = ((SA1 * wa1 + ka1 * v1) - ba1 * p1) + (kc1 * v2 - bc1 * p2);
            SB0 = ((SB0 * wb0 + kb0 * v1) - bb0 * p1) + (kd0 * v2 - bd0 * p2); SB1 = ((SB1 * wb1 + kb1 * v1) - bb1 * p1) + (kd1 * v2 - bd1 * p2);
            { u32x4 pk; pk.x = cvtpk(SA0.x, SA0.y); pk.y = cvtpk(SA0.z, SA0.w); pk.z = cvtpk(SA1.x, SA1.y); pk.w = cvtpk(SA1.z, SA1.w); sA = __builtin_bit_cast(bf16x8, pk); }
            { u32x4 pk; pk.x = cvtpk(SB0.x, SB0.y); pk.y = cvtpk(SB0.z, SB0.w); pk.z = cvtpk(SB1.x, SB1.y); pk.w = cvtpk(SB1.z, SB1.w); sB = __builtin_bit_cast(bf16x8, pk); }
            if (mq == 0) { LY[(2 * pi) * 64 + mi0] = y1; LY[(2 * pi + 1) * 64 + mi0] = y2; }
        }
        } else if (helper && blk + 1 < NB) { RW_STAGE(bi ^ 1); if (blk + 2 < NB) RW_LOAD(blk + 2); }
        lds_sync();
        {
            const int et = xtid >> 4;
            const f32x4 y = *(const LAS f32x4*)(LY + et * 64 + 4 * es);
            const f32x4 r = *(const LAS f32x4*)(LT + et * 64 + 4 * es), k = *(const LAS f32x4*)(LT + 2 * TS + et * 64 + 4 * es), v = *(const LAS f32x4*)(LT + 3 * TS + et * 64 + 4 * es);
            const f32x4 g = *(const LAS f32x4*)(LT + 6 * TS + et * 64 + 4 * es);
            const float mean = sum16(y.x + y.y + y.z + y.w) * (1.0f / 64.0f);
            const f32x4 d = y - mean;
            const float var = sum16(d.x * d.x + d.y * d.y + d.z * d.z + d.w * d.w) * (1.0f / 64.0f);
            const float rstd = frsq(var + kRwkvLnEps);
            const float bonus = sum16(r.x * k.x * rk.x + r.y * k.y * rk.y + r.z * k.z * rk.z + r.w * k.w * rk.w);
            u32x2 o;
            o.x = cvtpk((d.x * rstd * lnw.x + lnb.x + bonus * v.x) * g.x, (d.y * rstd * lnw.y + lnb.y + bonus * v.y) * g.y);
            o.y = cvtpk((d.z * rstd * lnw.z + lnb.z + bonus * v.z) * g.z, (d.w * rstd * lnw.w + lnb.w + bonus * v.w) * g.w);
            *(u32x2*)(F.O() + (tok0 + et) * kD + 1536 + ech) = o;
        }
        lds_sync();
    }
#undef RW_LOAD
#undef RW_STAGE
#undef PUT8
#undef PUTU
#undef DOT8
}

constexpr int CQ = 72, CT = 40;
constexpr int CL_QP = 0, CL_KP = 32 * CQ, CL_KT = 2 * 32 * CQ, CL_VT = CL_KT + 64 * CT, CL_PM = CL_VT + 80 * CT, CL_ST = CL_PM + 32 * CT, CL_E16 = CL_ST + 80 * CQ;
constexpr int CL_DEC = CL_E16 * 2;
constexpr int CL_RAW = CL_DEC + 256;
constexpr int CL_BYTES = CL_RAW + 16384;
static_assert(CL_RAW % 1024 == 0 || true, "raw");

template <int KIND> DEV void chain_abc(Frame& F, LAS unsigned char* wl, int l, int b, int hh) {
    constexpr int NTE = KIND == 2 ? 5 : 4;
    constexpr int NCH = kS / 32;
    LAS u16* QP = (LAS u16*)wl + CL_QP; LAS u16* KP = (LAS u16*)wl + CL_KP; LAS u16* KT = (LAS u16*)wl + CL_KT; LAS u16* VT = (LAS u16*)wl + CL_VT;
    LAS u16* PM = (LAS u16*)wl + CL_PM; LAS u16* ST = (LAS u16*)wl + CL_ST; LAS float* DEC = (LAS float*)(wl + CL_DEC); LAS u16* RAW = (LAS u16*)(wl + CL_RAW);
    int lane_ = F.lane;
#ifndef HOST_EMU
    asm volatile("" : "+v"(lane_));
#endif
    const int lane = lane_, d = lane, c = lane & 15, q = lane >> 4;
    const int pbase = KIND == 0 ? PC_RET : KIND == 1 ? PC_HG : PC_ML;
    const int obase = 512 * KIND + 64 * hh;
    const u16* pchain = F.P() + (size_t)b * kS * kNP + pbase + 64 * hh;
    float gam = 1.f, igam = 1.f, g32 = 1.f, cdl = 1.f, sdl = 0.f, tc_n = 1.f, ts_n = 0.f;
    float lb = 0.f;
    float cwq[4] = {0, 0, 0, 0}, cwk[4] = {0, 0, 0, 0}, cbq = 0.f, cbk = 0.f, ibias = 0.f, fbias = 0.f;
    float qh1 = 0.f, qh2 = 0.f, qh3 = 0.f, kh1 = 0.f, kh2 = 0.f, kh3 = 0.f;
    float nw[4] = {1.f, 1.f, 1.f, 1.f};
    float gi_n = 0.f, gf_n = 0.f;
    if (KIND == 0) { const float lg = log1pf(-exp2f(-5.0f - (float)hh)); gam = expf(lg); igam = expf(-lg); g32 = expf(32.0f * lg);
        const float* tr = F.TRIG() + 2 * (d & 31); tc_n = tr[0]; ts_n = tr[1]; cdl = tr[64]; sdl = tr[65]; }
    if (KIND == 1) {
        const float* lg4 = F.in(I_HLB) + 64 * hh + d; float e[4], mx = -1e30f, sm = 0.f;
#pragma unroll
        for (int i = 0; i < 4; ++i) { e[i] = lg4[i * 512]; mx = fmaxf(mx, e[i]); }
#pragma unroll
        for (int i = 0; i < 4; ++i) { e[i] = expf(e[i] - mx); sm += e[i]; }
#pragma unroll
        for (int i = 1; i < 4; ++i) if (i <= l) lb += e[i] / sm;
#pragma unroll
        for (int tn = 0; tn < 4; ++tn) nw[tn] = F.in(I_HNW)[l * 512 + 64 * hh + 16 * tn + c];
    }
    if (KIND == 2) {
        const float* cw = F.in(I_MCW) + (size_t)l * 4 * 1024;
#pragma unroll
        for (int j = 0; j < 4; ++j) { cwq[j] = cw[j * 1024 + 64 * hh + d]; cwk[j] = cw[j * 1024 + 512 + 64 * hh + d]; }
        cbq = F.in(I_MCB)[l * 1024 + 64 * hh + d]; cbk = F.in(I_MCB)[l * 1024 + 512 + 64 * hh + d];
        ibias = F.in(I_MIB)[l * 8 + hh]; fbias = F.in(I_MFB)[l * 8 + hh];
#pragma unroll
        for (int tn = 0; tn < 4; ++tn) nw[tn] = F.in(I_MNW)[l * 512 + 64 * hh + 16 * tn + c];
        for (int i = lane; i < 16 * CT; i += 64) VT[64 * CT + i] = (i < CT) ? (u16)0x3F80 : (u16)0;
    }
    for (int i = lane; i < 80 * CQ; i += 64) ST[i] = 0;
    f32x4 accS[4][NTE];
#pragma unroll
    for (int dm = 0; dm < 4; ++dm)
#pragma unroll
        for (int te = 0; te < NTE; ++te) accS[dm][te] = (f32x4){0.f, 0.f, 0.f, 0.f};
    const unsigned dma_off = (unsigned)((lane >> 3) * kNP + 8 * (lane & 7));
    const unsigned gate_off = (unsigned)(lane * kNP + hh);
    const unsigned st_off = (unsigned)((lane >> 3) * kD + 8 * (lane & 7));
    const u16* pgate = F.P() + (size_t)b * kS * kNP + PC_MLG;
    u16* uchain = F.O() + (size_t)b * kS * kD + obase;
#define CH_DMA(ch_) do { const u16* g_ = pchain + (size_t)(ch_) * 32 * kNP; \
        _Pragma("unroll") for (int T_ = 0; T_ < 4; ++T_) _Pragma("unroll") for (int rb_ = 0; rb_ < 4; ++rb_) glds16(g_ + (512 * T_ + 8 * rb_ * kNP) + dma_off, RAW + T_ * 2048 + rb_ * 512, lane); } while (0)
#define CH_DMA_RB(ch_, rb_) do { const u16* g_ = pchain + (size_t)(ch_) * 32 * kNP; \
        _Pragma("unroll") for (int T_ = 0; T_ < 4; ++T_) glds16(g_ + (512 * T_ + 8 * (rb_) * kNP) + dma_off, RAW + T_ * 2048 + (rb_) * 512, lane); } while (0)
#define CH_NEXT_RB(r_) do { if ((((r_) + 2) & 7) == 0 && ch + 1 < NCH) { asm volatile("s_waitcnt lgkmcnt(0)" ::: "memory"); CH_DMA_RB(ch + 1, (r_) >> 3); } } while (0)
    CH_DMA(0);
    if (KIND == 2 && lane < 32) { const u16* grow = pgate + gate_off; gi_n = bf2f(grow[0]); gf_n = bf2f(grow[8]); }
    wave_sync();

#pragma unroll 1
    for (int ch = 0; ch < NCH; ++ch) {
        const int t0 = ch * 32; const size_t tok0 = (size_t)b * kS + t0;
        float adec = 1.f;
        wait_vm0(); wave_sync();
        unsigned gpk[2][4][2];
#pragma unroll
        for (int tm = 0; tm < 2; ++tm)
#pragma unroll
            for (int j = 0; j < 4; ++j) { const LAS u16* gr = RAW + 3 * 2048 + (16 * tm + 4 * q + j) * 64 + c;
                gpk[tm][j][0] = (unsigned)gr[0] | ((unsigned)gr[16] << 16); gpk[tm][j][1] = (unsigned)gr[32] | ((unsigned)gr[48] << 16); }
        const float gi_c = gi_n, gf_c = gf_n;
        const int swz = (d >> 3) & 3;
#define KTV_IDX(r_) (d * CT + 8 * (((r_) >> 3) ^ swz) + ((r_) & 7))
        if (KIND == 0) {
            float qd = gam, kd = igam;
            float cs = tc_n, sn = ts_n;
#pragma unroll 2
            for (int r = 0; r < 32; r += 2) {
                float qx[2], kx[2]; u16 vb[2];
#pragma unroll
                for (int u = 0; u < 2; ++u) {
                    const float qv = bf2f(RAW[(r + u) * 64 + d]), kv = bf2f(RAW[2048 + (r + u) * 64 + d]); vb[u] = RAW[4096 + (r + u) * 64 + d];
                    const float qo = xswap32(qv, d < 32), ko = xswap32(kv, d < 32);
                    const float qr = d < 32 ? qv * cs - qo * sn : qo * sn + qv * cs;
                    const float kr = (d < 32 ? kv * cs - ko * sn : ko * sn + kv * cs) * 0.125f;
                    qx[u] = qr * qd; kx[u] = kr * kd; qd *= gam; kd *= igam;
                    { const float c2 = cs * cdl - sn * sdl; sn = sn * cdl + cs * sdl; cs = c2; }
                }
                const unsigned qp = cvtpk(qx[0], qx[1]), kp = cvtpk(kx[0], kx[1]);
                QP[r * CQ + d] = (u16)(qp & 0xffffu); QP[(r + 1) * CQ + d] = (u16)(qp >> 16); KP[r * CQ + d] = (u16)(kp & 0xffffu); KP[(r + 1) * CQ + d] = (u16)(kp >> 16);
                *(LAS unsigned*)(KT + KTV_IDX(r)) = kp; *(LAS unsigned*)(VT + KTV_IDX(r)) = (unsigned)vb[0] | ((unsigned)vb[1] << 16);
                CH_NEXT_RB(r);
            }
            adec = g32;
        } else if (KIND == 1) {
            float E = 1.f;
#pragma unroll 2
            for (int r = 0; r < 32; r += 2) {
                float qx[2], kx[2]; u16 vb[2];
#pragma unroll
                for (int u = 0; u < 2; ++u) {
                    const float qv = bf2f(RAW[(r + u) * 64 + d]), fv = bf2f(RAW[2048 + (r + u) * 64 + d]); vb[u] = RAW[4096 + (r + u) * 64 + d];
                    const float ft = lb + (1.0f - lb) * fsig(fv);
                    E = fmaxf(E * ft, 1e-30f);
                    qx[u] = qv * fsig(qv) * 0.125f * E; kx[u] = (1.0f - ft) * frcp(E);
                }
                const unsigned qp = cvtpk(qx[0], qx[1]), kp = cvtpk(kx[0], kx[1]);
                QP[r * CQ + d] = (u16)(qp & 0xffffu); QP[(r + 1) * CQ + d] = (u16)(qp >> 16); KP[r * CQ + d] = (u16)(kp & 0xffffu); KP[(r + 1) * CQ + d] = (u16)(kp >> 16);
                *(LAS unsigned*)(KT + KTV_IDX(r)) = kp; *(LAS unsigned*)(VT + KTV_IDX(r)) = (unsigned)vb[0] | ((unsigned)vb[1] << 16);
                CH_NEXT_RB(r);
            }
            DEC[d] = E;
        } else {
            const float li = gi_c + ibias, lf = logsig(gf_c + fbias);
            const float Fc = scan32(lf);
            const float eF = fexp(Fc), eK = fexp(li - Fc);
            adec = rdlane(eF, 31);
#pragma unroll
            for (int r = 0; r < 32; r += 2) {
                float qx[2], kx[2]; u16 vb[2];
#pragma unroll
                for (int u = 0; u < 2; ++u) {
                    const float eFr = rdlane(eF, r + u), eKr = rdlane(eK, r + u);
                    const float qv = bf2f(RAW[(r + u) * 64 + d]), kv = bf2f(RAW[2048 + (r + u) * 64 + d]); vb[u] = RAW[4096 + (r + u) * 64 + d];
                    float qc = cbq + cwq[0] * qh3 + cwq[1] * qh2 + cwq[2] * qh1 + cwq[3] * qv;
                    float kc = cbk + cwk[0] * kh3 + cwk[1] * kh2 + cwk[2] * kh1 + cwk[3] * kv;
                    qh3 = qh2; qh2 = qh1; qh1 = qv; kh3 = kh2; kh2 = kh1; kh1 = kv;
                    qx[u] = qc * fsig(qc) * eFr; kx[u] = kc * fsig(kc) * 0.125f * eKr;
                }
                const unsigned qp = cvtpk(qx[0], qx[1]), kp = cvtpk(kx[0], kx[1]);
                QP[r * CQ + d] = (u16)(qp & 0xffffu); QP[(r + 1) * CQ + d] = (u16)(qp >> 16); KP[r * CQ + d] = (u16)(kp & 0xffffu); KP[(r + 1) * CQ + d] = (u16)(kp >> 16);
                *(LAS unsigned*)(KT + KTV_IDX(r)) = kp; *(LAS unsigned*)(VT + KTV_IDX(r)) = (unsigned)vb[0] | ((unsigned)vb[1] << 16);
                CH_NEXT_RB(r);
            }
        }
#undef KTV_IDX
        wave_sync();
        if (ch + 1 < NCH) {
            if (KIND == 2 && lane < 32) { unsigned go_ = gate_off;
#ifndef HOST_EMU
                asm volatile("" : "+v"(go_));
#endif
                const u16* grow = pgate + (size_t)(t0 + 32) * kNP + go_; gi_n = bf2f(grow[0]); gf_n = bf2f(grow[8]); }
            if (KIND == 0) { const float* tr = F.TRIG() + 2 * ((t0 + 32) * 32 + (d & 31)); tc_n = tr[0]; ts_n = tr[1]; }
        }
        bf16x8 qa[2][2];
        {
            bf16x8 kb[2][2];
#pragma unroll
            for (int x = 0; x < 2; ++x)
#pragma unroll
                for (int ks = 0; ks < 2; ++ks) { qa[x][ks] = ldsfrag(QP, CQ, 16 * x + c, 32 * ks + 8 * q); kb[x][ks] = ldsfrag(KP, CQ, 16 * x + c, 32 * ks + 8 * q); }
#pragma unroll
            for (int tm = 0; tm < 2; ++tm)
#pragma unroll
                for (int sn = 0; sn < 2; ++sn) {
                    f32x4 acc = {0.f, 0.f, 0.f, 0.f};
                    if (sn <= tm) {
#pragma unroll
                        for (int ks = 0; ks < 2; ++ks) acc = mfma16(kb[sn][ks], qa[tm][ks], acc);
                    }
                    const int t = 16 * tm + c, sb = 16 * sn + 4 * q;
                    u32x2 pk; pk.x = cvtpk(sb <= t ? acc[0] : 0.f, sb + 1 <= t ? acc[1] : 0.f); pk.y = cvtpk(sb + 2 <= t ? acc[2] : 0.f, sb + 3 <= t ? acc[3] : 0.f);
                    *(LAS u32x2*)(PM + t * CT + sb) = pk;
                }
        }
        wave_sync();
        {
#pragma unroll
            for (int tm = 0; tm < 2; ++tm) {
                const bf16x8 pa = ldsfrag(PM, CT, 16 * tm + c, 8 * q);
                f32x4 out[NTE];
#pragma unroll
                for (int te = 0; te < NTE; ++te) {
                    const int row = 16 * te + c;
                    const bf16x8 vt = ldsfrag(VT, CT, row, 8 * (q ^ ((row >> 3) & 3))), st0 = ldsfrag(ST, CQ, row, 8 * q), st1 = ldsfrag(ST, CQ, row, 32 + 8 * q);
                    f32x4 acc = {0.f, 0.f, 0.f, 0.f};
                    acc = mfma16(pa, vt, acc); acc = mfma16(qa[tm][0], st0, acc); acc = mfma16(qa[tm][1], st1, acc);
                    out[te] = acc;
                }
#pragma unroll
                for (int j = 0; j < 4; ++j) {
                    float v[4];
#pragma unroll
                    for (int te = 0; te < 4; ++te) v[te] = out[te][j];
                    if (KIND == 2) { const float den = sum16(out[NTE - 1][j]);     const float sc = frcp(fmaxf(fabsf(den), 1.0f));
#pragma unroll
                        for (int te = 0; te < 4; ++te) v[te] *= sc; }
                    const float ss = sum16(v[0] * v[0] + v[1] * v[1] + v[2] * v[2] + v[3] * v[3]);
                    const float rs = frsq(ss * (1.0f / 64.0f) + kNormEps);
#pragma unroll
                    for (int te = 0; te < 4; ++te) { const unsigned gw = gpk[tm][j][te >> 1]; const float g = bf2f((u16)((te & 1) ? (gw >> 16) : (gw & 0xffffu)));
                        const float gate = KIND == 0 ? g * fsig(g) : fsig(g);
                        KP[(16 * tm + 4 * q + j) * CQ + 16 * te + c] = (u16)(cvtpk(v[te] * rs * nw[te] * gate, 0.f) & 0xffffu); }
                }
            }
        }
        wave_sync();
#pragma unroll
        for (int i = 0; i < 4; ++i) { const int row = 8 * i + (lane >> 3), cg = lane & 7;
            *(u32x4*)(uchain + (size_t)(t0 + 8 * i) * kD + st_off) = *(const LAS u32x4*)(KP + row * CQ + 8 * cg); }
        {
            bf16x8 vt[NTE], kt[4];
#pragma unroll
            for (int te = 0; te < NTE; ++te) { const int row = 16 * te + c; vt[te] = ldsfrag(VT, CT, row, 8 * (q ^ ((row >> 3) & 3))); }
#pragma unroll
            for (int dm = 0; dm < 4; ++dm) { const int row = 16 * dm + c; kt[dm] = ldsfrag(KT, CT, row, 8 * (q ^ ((row >> 3) & 3))); }
#pragma unroll
            for (int dm = 0; dm < 4; ++dm) {
                f32x4 av;
                if (KIND == 1) av = *(const LAS f32x4*)(DEC + 16 * dm + 4 * q); else av = (f32x4){adec, adec, adec, adec};
#pragma unroll
                for (int te = 0; te < NTE; ++te) {
                    f32x4 acc = mfma16(kt[dm], vt[te], accS[dm][te]);
                    acc = acc * av; accS[dm][te] = acc;
                    u32x2 pk; pk.x = cvtpk(acc[0], acc[1]); pk.y = cvtpk(acc[2], acc[3]);
                    *(LAS u32x2*)(ST + (16 * te + c) * CQ + 16 * dm + 4 * q) = pk;
                }
            }
        }
        wave_sync();
    }
#undef CH_DMA
#undef CH_DMA_RB
#undef CH_NEXT_RB
}

constexpr int RL_RAW = 0;
constexpr int RL_AL = RL_RAW + 7 * 2048, RL_BE = RL_AL + 2304, RL_KA = RL_BE + 2304, RL_RH = RL_KA + 2304, RL_RK = RL_RH + 2304;
constexpr int RL_BET = RL_RK + 2304, RL_KAT = RL_BET + 2048, RL_VT = RL_KAT + 2048, RL_UT = RL_VT + 2048, RL_ZT = RL_UT + 2048;
constexpr int RL_BM = RL_ZT + 2048, RL_CM = RL_BM + 512, RL_DM = RL_CM + 512, RL_TI = RL_DM + 512, RL_AF = RL_TI + 512;
constexpr int RL_SI = RL_AF + 1024, RL_DEC = RL_SI + 64 * 72 * 2, RL_ZERO = RL_DEC + 256, RL_OT = RL_ZERO + 64, RL_END = RL_OT + 2048;
static_assert(RL_END <= CL_BYTES, "rwkv chain lds");
DEV bf16x8 fragT(const LAS u16* base, const LAS u16* zero, int row, int q) { return *(const LAS bf16x8*)(q < 2 ? base + row * 16 + 8 * q : zero); }

DEV void chain_rwkv(Frame& F, LAS unsigned char* wl, int l, int b, int hh) {
    constexpr int NCH = kS / 16;
    LAS u16* RAW = (LAS u16*)(wl + RL_RAW); LAS u16* AL = (LAS u16*)(wl + RL_AL); LAS u16* BE = (LAS u16*)(wl + RL_BE); LAS u16* KA = (LAS u16*)(wl + RL_KA); LAS u16* RH = (LAS u16*)(wl + RL_RH); LAS u16* RK = (LAS u16*)(wl + RL_RK);
    LAS u16* BET = (LAS u16*)(wl + RL_BET); LAS u16* KAT = (LAS u16*)(wl + RL_KAT); LAS u16* VT = (LAS u16*)(wl + RL_VT); LAS u16* UT = (LAS u16*)(wl + RL_UT); LAS u16* ZT = (LAS u16*)(wl + RL_ZT);
    LAS u16* BM = (LAS u16*)(wl + RL_BM); LAS u16* CM = (LAS u16*)(wl + RL_CM); LAS u16* DM = (LAS u16*)(wl + RL_DM); LAS u16* TI = (LAS u16*)(wl + RL_TI); LAS float* AF = (LAS float*)(wl + RL_AF);
    LAS u16* SI = (LAS u16*)(wl + RL_SI); LAS float* DEC = (LAS float*)(wl + RL_DEC); LAS u16* ZERO = (LAS u16*)(wl + RL_ZERO); LAS u16* OT = (LAS u16*)(wl + RL_OT);
    int lane_ = F.lane;
#ifndef HOST_EMU
    asm volatile("" : "+v"(lane_));
#endif
    const int lane = lane_, d = lane, c = lane & 15, q = lane >> 4;
    const float rkd = F.in(I_RK)[l * 512 + 64 * hh + d];
    float lnw[4], lnb[4];
#pragma unroll
    for (int tv = 0; tv < 4; ++tv) { lnw[tv] = F.in(I_LNW)[l * 512 + 64 * hh + 16 * tv + c]; lnb[tv] = F.in(I_LNB)[l * 512 + 64 * hh + 16 * tv + c]; }
    for (int i = lane; i < 64 * 72; i += 64) SI[i] = 0;
    if (lane < 32) ZERO[lane] = 0;
    f32x4 accH[4][4];
#pragma unroll
    for (int tk = 0; tk < 4; ++tk)
#pragma unroll
        for (int tv = 0; tv < 4; ++tv) accH[tk][tv] = (f32x4){0.f, 0.f, 0.f, 0.f};
    const u16* rws = F.RWS() + (size_t)b * kS * kRWS + 64 * hh;
    u16* ochain = F.O() + (size_t)b * kS * kD + 1536 + 64 * hh;
    const unsigned dma_off = (unsigned)((lane >> 3) * kRWS + 8 * (lane & 7));
    const unsigned st_off = (unsigned)((lane >> 3) * kD + 8 * (lane & 7));
#define RW_DMA(ch_) do { const u16* g_ = rws + (size_t)(ch_) * 16 * kRWS; \
        _Pragma("unroll") for (int T_ = 0; T_ < 7; ++T_) _Pragma("unroll") for (int rb_ = 0; rb_ < 2; ++rb_) glds16(g_ + (512 * T_ + 8 * rb_ * kRWS) + dma_off, RAW + T_ * 1024 + rb_ * 512, lane); } while (0)
    RW_DMA(0);
    wave_sync();
#pragma unroll 1
    for (int ch = 0; ch < NCH; ++ch) {
        const int t0 = ch * 16;
        wait_vm0(); wave_sync();
        float Wc = 1.f;
#pragma unroll 4
        for (int j = 0; j < 16; j += 2) {
            float al[2], be[2], ka[2], rh[2], rk2[2]; u16 vb[2];
#pragma unroll
            for (int u = 0; u < 2; ++u) {
                const int o = (j + u) * 64 + d;
                const float rv = bf2f(RAW[o]), wv = bf2f(RAW[1024 + o]), kv = bf2f(RAW[2048 + o]), kkv = bf2f(RAW[4096 + o]), bv = bf2f(RAW[5120 + o]); vb[u] = RAW[3072 + o];
                al[u] = kkv * Wc; Wc *= wv; const float iw = frcp(Wc);
                be[u] = bv * iw; ka[u] = kv * iw; rh[u] = rv * Wc; rk2[u] = rv * rkd;
            }
            const unsigned pa = cvtpk(al[0], al[1]), pb = cvtpk(be[0], be[1]), pk = cvtpk(ka[0], ka[1]), pr = cvtpk(rh[0], rh[1]), pq = cvtpk(rk2[0], rk2[1]), pn = cvtpk(-be[0], -be[1]);
            AL[j * 72 + d] = (u16)(pa & 0xffffu); AL[(j + 1) * 72 + d] = (u16)(pa >> 16); BE[j * 72 + d] = (u16)(pb & 0xffffu); BE[(j + 1) * 72 + d] = (u16)(pb >> 16);
            KA[j * 72 + d] = (u16)(pk & 0xffffu); KA[(j + 1) * 72 + d] = (u16)(pk >> 16); RH[j * 72 + d] = (u16)(pr & 0xffffu); RH[(j + 1) * 72 + d] = (u16)(pr >> 16);
            RK[j * 72 + d] = (u16)(pq & 0xffffu); RK[(j + 1) * 72 + d] = (u16)(pq >> 16);
            *(LAS unsigned*)(BET + d * 16 + j) = pn; *(LAS unsigned*)(KAT + d * 16 + j) = pk; *(LAS unsigned*)(VT + d * 16 + j) = (unsigned)vb[0] | ((unsigned)vb[1] << 16);
        }
        DEC[d] = Wc;
        wave_sync();
        {
            bf16x8 fa[2], fb[2], fk[2], fr[2];
#pragma unroll
            for (int ks = 0; ks < 2; ++ks) { fa[ks] = ldsfrag(AL, 72, c, 32 * ks + 8 * q); fb[ks] = ldsfrag(BE, 72, c, 32 * ks + 8 * q); fk[ks] = ldsfrag(KA, 72, c, 32 * ks + 8 * q); fr[ks] = ldsfrag(RH, 72, c, 32 * ks + 8 * q); }
            f32x4 mA = {0.f, 0.f, 0.f, 0.f}, mB = mA, mC = mA, mD = mA;
#pragma unroll
            for (int ks = 0; ks < 2; ++ks) { mA = mfma16(fb[ks], fa[ks], mA); mB = mfma16(fk[ks], fa[ks], mB); mC = mfma16(fb[ks], fr[ks], mC); mD = mfma16(fk[ks], fr[ks], mD); }
            const int sb = 4 * q;
            *(LAS f32x4*)(AF + c * 16 + sb) = (f32x4){sb < c ? mA[0] : 0.f, sb + 1 < c ? mA[1] : 0.f, sb + 2 < c ? mA[2] : 0.f, sb + 3 < c ? mA[3] : 0.f};
            u32x2 w2;
            w2.x = cvtpk(sb < c ? mB[0] : 0.f, sb + 1 < c ? mB[1] : 0.f); w2.y = cvtpk(sb + 2 < c ? mB[2] : 0.f, sb + 3 < c ? mB[3] : 0.f); *(LAS u32x2*)(BM + c * 16 + sb) = w2;
            w2.x = cvtpk(sb <= c ? -mC[0] : 0.f, sb + 1 <= c ? -mC[1] : 0.f); w2.y = cvtpk(sb + 2 <= c ? -mC[2] : 0.f, sb + 3 <= c ? -mC[3] : 0.f); *(LAS u32x2*)(CM + c * 16 + sb) = w2;
            w2.x = cvtpk(sb <= c ? mD[0] : 0.f, sb + 1 <= c ? mD[1] : 0.f); w2.y = cvtpk(sb + 2 <= c ? mD[2] : 0.f, sb + 3 <= c ? mD[3] : 0.f); *(LAS u32x2*)(DM + c * 16 + sb) = w2;
        }
        float bonus[4];
        {
            f32x4 mb = {0.f, 0.f, 0.f, 0.f};
#pragma unroll
            for (int ks = 0; ks < 2; ++ks) mb = mfma16(ldsfrag(RK, 72, c, 32 * ks + 8 * q), ldsfrag(RAW + 2048, 64, c, 32 * ks + 8 * q), mb);
#pragma unroll
            for (int i = 0; i < 4; ++i) bonus[i] = sum16(c == 4 * q + i ? mb[i] : 0.f);
        }
        unsigned vg[4][4];
#pragma unroll
        for (int i = 0; i < 4; ++i)
#pragma unroll
            for (int tv = 0; tv < 4; ++tv) { const int o = (4 * q + i) * 64 + 16 * tv + c; vg[i][tv] = (unsigned)RAW[3072 + o] | ((unsigned)RAW[6144 + o] << 16); }
        wave_sync();
        if (ch + 1 < NCH) RW_DMA(ch + 1);
        {
            float t[16];
            const int scol = lane & 15;
            f32x4 af[16][4];
#pragma unroll
            for (int j = 1; j < 16; ++j)
#pragma unroll
                for (int m4 = 0; m4 < (j + 3) / 4; ++m4) af[j][m4] = *(const LAS f32x4*)(AF + j * 16 + 4 * m4);
#pragma unroll
            for (int j = 0; j < 16; ++j) {
                float acc0 = (j == scol) ? 1.f : 0.f, acc1 = 0.f;
#pragma unroll
                for (int m = 0; m < j; ++m) { if (m & 1) acc1 -= af[j][m >> 2][m & 3] * t[m]; else acc0 -= af[j][m >> 2][m & 3] * t[m]; }
                t[j] = acc0 + acc1;
            }
            if (lane < 16) {
#pragma unroll
                for (int j = 0; j < 16; ++j) TI[j * 16 + scol] = (u16)(cvtpk(t[j], 0.f) & 0xffffu); }
        }
        wave_sync();
        {
            const bf16x8 a0 = ldsfrag(AL, 72, c, 8 * q), a1 = ldsfrag(AL, 72, c, 32 + 8 * q), bm = fragT(BM, ZERO, c, q);
#pragma unroll
            for (int tv = 0; tv < 4; ++tv) { const int row = 16 * tv + c;
                f32x4 z = {0.f, 0.f, 0.f, 0.f};
                z = mfma16(a0, ldsfrag(SI, 72, row, 8 * q), z); z = mfma16(a1, ldsfrag(SI, 72, row, 32 + 8 * q), z); z = mfma16(bm, fragT(VT, ZERO, row, q), z);
                u32x2 w2; w2.x = cvtpk(z[0], z[1]); w2.y = cvtpk(z[2], z[3]); *(LAS u32x2*)(ZT + row * 16 + 4 * q) = w2; }
        }
        wave_sync();
        {
            const bf16x8 ti = fragT(TI, ZERO, c, q);
#pragma unroll
            for (int tv = 0; tv < 4; ++tv) { const int row = 16 * tv + c;
                f32x4 u = {0.f, 0.f, 0.f, 0.f};
                u = mfma16(ti, fragT(ZT, ZERO, row, q), u);
                u32x2 w2; w2.x = cvtpk(u[0], u[1]); w2.y = cvtpk(u[2], u[3]); *(LAS u32x2*)(UT + row * 16 + 4 * q) = w2; }
        }
        wave_sync();
        {
            const bf16x8 r0 = ldsfrag(RH, 72, c, 8 * q), r1 = ldsfrag(RH, 72, c, 32 + 8 * q), cm = fragT(CM, ZERO, c, q), dm = fragT(DM, ZERO, c, q);
            f32x4 y[4];
#pragma unroll
            for (int tv = 0; tv < 4; ++tv) { const int row = 16 * tv + c;
                f32x4 a = {0.f, 0.f, 0.f, 0.f};
                a = mfma16(r0, ldsfrag(SI, 72, row, 8 * q), a); a = mfma16(r1, ldsfrag(SI, 72, row, 32 + 8 * q), a);
                a = mfma16(cm, fragT(UT, ZERO, row, q), a); a = mfma16(dm, fragT(VT, ZERO, row, q), a);
                y[tv] = a; }
#pragma unroll
            for (int i = 0; i < 4; ++i) {
                const float mean = sum16((y[0][i] + y[1][i]) + (y[2][i] + y[3][i])) * (1.0f / 64.0f);
                const float d0 = y[0][i] - mean, d1 = y[1][i] - mean, d2 = y[2][i] - mean, d3 = y[3][i] - mean;
                const float var = sum16((d0 * d0 + d1 * d1) + (d2 * d2 + d3 * d3)) * (1.0f / 64.0f);
                const float rstd = frsq(var + kRwkvLnEps);
                const float dd[4] = {d0, d1, d2, d3};
#pragma unroll
                for (int tv = 0; tv < 4; ++tv) { const float vv = bf2f((u16)(vg[i][tv] & 0xffffu)), gg = bf2f((u16)(vg[i][tv] >> 16));
                    OT[(4 * q + i) * 64 + 16 * tv + c] = (u16)(cvtpk((dd[tv] * rstd * lnw[tv] + lnb[tv] + bonus[i] * vv) * gg, 0.f) & 0xffffu); }
            }
        }
        wave_sync();
#pragma unroll
        for (int i = 0; i < 2; ++i) { const int row = 8 * i + (lane >> 3), cg = lane & 7;
            *(u32x4*)(ochain + (size_t)(t0 + 8 * i) * kD + st_off) = *(const LAS u32x4*)(OT + row * 64 + 8 * cg); }
        {
            bf16x8 ut[4], vt[4];
#pragma unroll
            for (int tv = 0; tv < 4; ++tv) { ut[tv] = fragT(UT, ZERO, 16 * tv + c, q); vt[tv] = fragT(VT, ZERO, 16 * tv + c, q); }
#pragma unroll
            for (int tk = 0; tk < 4; ++tk) {
                const bf16x8 nb = fragT(BET, ZERO, 16 * tk + c, q), kt = fragT(KAT, ZERO, 16 * tk + c, q);
                const f32x4 dv = *(const LAS f32x4*)(DEC + 16 * tk + 4 * q);
#pragma unroll
                for (int tv = 0; tv < 4; ++tv) {
                    f32x4 h = mfma16(nb, ut[tv], accH[tk][tv]); h = mfma16(kt, vt[tv], h);
                    h = h * dv; accH[tk][tv] = h;
                    u32x2 w2; w2.x = cvtpk(h[0], h[1]); w2.y = cvtpk(h[2], h[3]);
                    *(LAS u32x2*)(SI + (16 * tv + c) * 72 + 16 * tk + 4 * q) = w2;
                }
            }
        }
        wave_sync();
    }
#undef RW_DMA
}

#ifndef KMASK
#define KMASK 15
#endif
#ifndef RWKV_CHUNKED
#define RWKV_CHUNKED 0
#endif
DEV void mix_phase(Frame& F, int l) {
#if RWKV_CHUNKED
    constexpr int NCHAIN = 4 * kB * kH, NITEM = (NCHAIN + 2) / 3;
    for (int item = F.bid; item < NITEM; item += F.G) {
        const int cid = item * 3 + F.wave;
#ifndef HOST_EMU
        if (F.wave >= 3) {
            if (l == 0) for (int it = CV_N0 + CV_N1 + item * 5 + (F.wave - 3); it < CV_NT; it += NITEM * 5) conv_wave_tile(F, 0, it, F.lane);
            if (l + 1 < kL) for (int it = item * 5 + (F.wave - 3); it < CV_NT; it += NITEM * 5) conv_wave_tile(F, l + 1, it, F.lane);
        }
#endif
        if (F.wave < 3 && cid < NCHAIN) {
            const int kind = cid % 4, r = cid / 4;
            LAS unsigned char* wl = F.lds + F.wave * CL_BYTES;
            if ((KMASK & 1) && kind == 0) chain_abc<0>(F, wl, l, r / kH, r % kH);
            else if ((KMASK & 2) && kind == 1) chain_abc<1>(F, wl, l, r / kH, r % kH);
            else if ((KMASK & 4) && kind == 2) chain_abc<2>(F, wl, l, r / kH, r % kH);
            else if ((KMASK & 8) && kind == 3) chain_rwkv(F, wl, l, r / kH, r % kH);
        }
        __syncthreads();
    }
#else
    constexpr int NRW = kB * kH, NABC = 3 * kB * kH, NITEM = NRW + (NABC + 2) / 3;
    for (int item = F.bid; item < NITEM; item += F.G) {
        if (item < NRW) { if (KMASK & 8) rwkv_scan(F, l, item / kH, item % kH); }
        else {
            const int cid = (item - NRW) * 3 + F.wave;
#ifndef HOST_EMU
            if (F.wave >= 3) {
                if (l == 0) for (int it = CV_N0 + CV_N1 + (item - NRW) * 5 + (F.wave - 3); it < CV_NT; it += (NITEM - NRW) * 5) conv_wave_tile(F, 0, it, F.lane);
                if (l + 1 < kL) for (int it = (item - NRW) * 5 + (F.wave - 3); it < CV_NT; it += (NITEM - NRW) * 5) conv_wave_tile(F, l + 1, it, F.lane);
            }
#endif
            if (F.wave < 3 && cid < NABC) {
                const int kind = cid / (kB * kH), r = cid % (kB * kH);
                LAS unsigned char* wl = F.lds + F.wave * CL_BYTES;
                if ((KMASK & 1) && kind == 0) chain_abc<0>(F, wl, l, r / kH, r % kH);
                else if ((KMASK & 2) && kind == 1) chain_abc<1>(F, wl, l, r / kH, r % kH);
                else if ((KMASK & 4) && kind == 2) chain_abc<2>(F, wl, l, r / kH, r % kH);
            }
            __syncthreads();
        }
    }
#endif
}

template <int MODE> DEV void simple_gemm_phase(Frame& F, const u16* A, const u16* Bt, int M, int N, int K, u16* O, int ldo) {
    LAS u16* As = (LAS u16*)F.lds;
    LAS u16* Bs = (LAS u16*)F.lds + 128 * 40;
    const int c = F.lane & 15, q = F.lane >> 4, w = F.wave;
    const int NT = MODE == 0 ? N / 64 : N / 128, MT = M / 128;
    for (int tile = F.bid; tile < MT * NT; tile += F.G) {
        const int tm = tile / NT, tn = tile % NT;
        f32x4 acc[2][4];
#pragma unroll
        for (int h = 0; h < 2; ++h)
#pragma unroll
            for (int j = 0; j < 4; ++j) acc[h][j] = (f32x4){0.f, 0.f, 0.f, 0.f};
        for (int k0 = 0; k0 < K; k0 += 32) {
            { const int r = F.tid >> 2, g = F.tid & 3; *(LAS u32x4*)(As + r * 40 + 8 * g) = *(const u32x4*)(A + (size_t)(tm * 128 + r) * K + k0 + 8 * g); }
            if (MODE == 0) { if (F.tid < 256) { const int r = F.tid >> 2, g = F.tid & 3; *(LAS u32x4*)(Bs + r * 40 + 8 * g) = *(const u32x4*)(Bt + (size_t)(tn * 64 + r) * K + k0 + 8 * g); } }
            else { const int r = F.tid >> 2, g = F.tid & 3; const int un = tn >> 1, off = (tn & 1) * 64; const int brow = un * 256 + (r < 64 ? off + r : 128 + off + (r - 64));
                *(LAS u32x4*)(Bs + r * 40 + 8 * g) = *(const u32x4*)(Bt + (size_t)brow * K + k0 + 8 * g); }
            __syncthreads();
            const bf16x8 af = ldsfrag(As, 40, 16 * w + c, 8 * q);
#pragma unroll
            for (int h = 0; h < (MODE == 0 ? 1 : 2); ++h)
#pragma unroll
                for (int j = 0; j < 4; ++j) acc[h][j] = mfma16(af, ldsfrag(Bs, 40, 64 * h + 16 * j + c, 8 * q), acc[h][j]);
            __syncthreads();
        }
#pragma unroll
        for (int j = 0; j < 4; ++j)
#pragma unroll
            for (int i = 0; i < 4; ++i) { const size_t row = (size_t)tm * 128 + 16 * w + 4 * q + i; const int col = tn * 64 + 16 * j + c;
                if (MODE == 0) O[row * ldo + col] = f2bf(acc[0][j][i]);
                else { const float g = acc[0][j][i], up = acc[1][j][i]; O[row * ldo + col] = f2bf(g / (1.0f + expf(-g)) * up); } }
    }
}

#ifndef HOST_EMU
__device__ __forceinline__ unsigned xb_ld(unsigned* p);
__device__ __forceinline__ unsigned xb_add(unsigned* p, unsigned v);
namespace pg8 {
#define PG8_LAS __attribute__((address_space(3)))
typedef unsigned short bf16_t;
constexpr int BM = 256, BK = 64, HALF = 128, HTB = HALF * BK * 2, STAGE_BYTES = 8 * HTB, NXCD = 8, WGM = 4;
__host__ __device__ __forceinline__ int lds_byte(int r, int c) { const int st = (r >> 4) * 2 + (c >> 5), rr = r & 15, cc = c & 31, ob = rr * 64 + cc * 2; return st * 1024 + (ob ^ (((ob >> 9) & 1) << 5)); }
__host__ __device__ __forceinline__ void stage_rc(int b, int& R, int& C) { const int st = b / 1024, sb = b % 1024, swz = sb ^ (((sb >> 9) & 1) << 5); R = (st >> 1) * 16 + swz / 64; C = (st & 1) * 32 + (swz % 64) / 2; }
__host__ __device__ __forceinline__ int perm32(int rho) { const int n = rho >> 4, i = rho & 15; return 8 * (i >> 2) + 4 * n + (i & 3); }
struct Unit { int pm, pn; };
struct Gemm { const bf16_t* A; const bf16_t* Bt; int M, N, K; };
struct StaticOrder {
    int nM, nN, nwg, G, c;
    __host__ __device__ void init(int M, int N, int G_, int c_) { nM = M / BM; nN = N / BM; nwg = nM * nN; G = G_; c = c_; }
    __host__ __device__ bool next(int i, Unit& u) const {
        const long L = (long)i * G + c; if (L >= nwg) return false;
        int wgid = (int)L; { const int q = nwg / NXCD, r = nwg % NXCD, xcd = wgid % NXCD, off = wgid / NXCD; wgid = (xcd < r ? xcd * (q + 1) : r * (q + 1) + (xcd - r) * q) + off; }
        const int nig = WGM * nN, gid = wgid / nig, fm = gid * WGM, gsz = (nM - fm) < WGM ? (nM - fm) : WGM;
        u.pm = fm + ((wgid % nig) % gsz); u.pn = (wgid % nig) / gsz; return true;
    }
    __device__ __forceinline__ void a_ready(const Unit&) const {}
    __device__ __forceinline__ void done(const Unit&) const {}
};
__device__ __forceinline__ unsigned cvt_pk_bf16(float lo, float hi) { unsigned r; asm volatile("v_cvt_pk_bf16_f32 %0, %1, %2" : "=v"(r) : "v"(lo), "v"(hi)); return r; }
template <bool SCALE> struct EpiBf16 {
    static constexpr bool PERM = true, AFTER_DRAIN = false, HAS_SCALE = SCALE;
    bf16_t* O; int ldc; const float* rs; PG8_LAS float* scl;
    __device__ __forceinline__ void prefetch(const Unit& u, int par, int wid, int lane) const {
        if (SCALE && wid < 4) __builtin_amdgcn_global_load_lds((const unsigned*)(rs + u.pm * BM + 64 * wid + lane), (PG8_LAS unsigned*)(scl + par * 256 + 64 * wid), 4, 0, 0); }
    __device__ __forceinline__ void operator()(const f32x4 (&acc)[2][2][4][2], const Unit& u, int wr, int wc, int fr, int fq, int par) const {
        const int row0 = u.pm * BM + wr * 64 + fr; const int col0 = u.pn * BM + wc * 32 + 8 * fq;
#pragma unroll
        for (int ai = 0; ai < 2; ++ai)
#pragma unroll
            for (int m = 0; m < 4; ++m) { bf16_t* rowp = O + (size_t)(row0 + ai * HALF + m * 16) * ldc + col0; const float sc = SCALE ? scl[par * 256 + wr * 64 + fr + ai * HALF + m * 16] : 1.0f;
#pragma unroll
                for (int bj = 0; bj < 2; ++bj) { const f32x4 v0 = acc[ai][bj][m][0] * sc, v1 = acc[ai][bj][m][1] * sc;
                    u32x4 w; w.x = cvt_pk_bf16(v0[0], v0[1]); w.y = cvt_pk_bf16(v0[2], v0[3]); w.z = cvt_pk_bf16(v1[0], v1[1]); w.w = cvt_pk_bf16(v1[2], v1[3]);
                    if (SCALE) __builtin_nontemporal_store(w, (u32x4*)(rowp + bj * HALF)); else *(u32x4*)(rowp + bj * HALF) = w; } }
    }
};
struct EpiSwiGlu {
    static constexpr bool PERM = true, AFTER_DRAIN = false, HAS_SCALE = true;
    bf16_t* O; int ldc; const float* rs; PG8_LAS float* scl;
    __device__ __forceinline__ void prefetch(const Unit& u, int par, int wid, int lane) const {
        if (wid < 4) __builtin_amdgcn_global_load_lds((const unsigned*)(rs + u.pm * BM + 64 * wid + lane), (PG8_LAS unsigned*)(scl + par * 256 + 64 * wid), 4, 0, 0); }
    __device__ __forceinline__ void operator()(const f32x4 (&acc)[2][2][4][2], const Unit& u, int wr, int wc, int fr, int fq, int par) const {
        const int row0 = u.pm * BM + wr * 64 + fr; const int col0 = u.pn * HALF + wc * 32 + 8 * fq;
#pragma unroll
        for (int ai = 0; ai < 2; ++ai)
#pragma unroll
            for (int m = 0; m < 4; ++m) { bf16_t* rowp = O + (size_t)(row0 + ai * HALF + m * 16) * ldc + col0; const float sc = scl[par * 256 + wr * 64 + fr + ai * HALF + m * 16];
                float o[8];
#pragma unroll
                for (int n = 0; n < 2; ++n)
#pragma unroll
                    for (int j = 0; j < 4; ++j) { const float g = acc[ai][0][m][n][j] * sc, up = acc[ai][1][m][n][j] * sc; o[4 * n + j] = g * __builtin_amdgcn_rcpf(1.0f + __expf(-g)) * up; }
                u32x4 w; w.x = cvt_pk_bf16(o[0], o[1]); w.y = cvt_pk_bf16(o[2], o[3]); w.z = cvt_pk_bf16(o[4], o[5]); w.w = cvt_pk_bf16(o[6], o[7]);
                __builtin_nontemporal_store(w, (u32x4*)rowp); }
    }
};

struct PanelOrder {
    int nM, ngrp, g, pn;
    __device__ void init(int M, int G_, int c_) { nM = M / BM; ngrp = G_ / 8;
        if (G_ % 64 == 0) { const int x = c_ & 7, j = c_ >> 3; g = x + 8 * (j >> 3); pn = j & 7; } else { g = c_ >> 3; pn = c_ & 7; }
        if (c_ >= 8 * ngrp) g = 1 << 28; }
    __device__ bool next(int i, Unit& u) const { const long pm = (long)i * ngrp + g; if (pm >= nM) return false; u.pm = (int)pm; u.pn = pn; return true; }
    __device__ __forceinline__ void a_ready(const Unit&) const {}
    __device__ __forceinline__ void done(const Unit&) const {}
};
#define PG8_EPI_BAR() do { asm volatile("s_waitcnt vmcnt(0) lgkmcnt(0)" ::: "memory"); __builtin_amdgcn_s_barrier(); } while (0)
template <bool FINAL> struct EpiResNorm {
    static constexpr bool PERM = true, AFTER_DRAIN = false, HAS_SCALE = false;
    float* OUT; bf16_t* H; const float* gy; float* XP; float* XQ; float* R2; unsigned* cnt; unsigned* tmo; PG8_LAS float* red;
    __device__ __forceinline__ void prefetch(const Unit&, int, int, int) const {}
    __device__ __forceinline__ float rowsum(int row) const { float t = 0.f;
#pragma unroll
        for (int s_ = 0; s_ < 16; ++s_) t += red[s_ * 256 + row];
        return t; }
    static __device__ __forceinline__ void xst(float* p, float v) { __hip_atomic_store(p, v, __ATOMIC_RELAXED, __HIP_MEMORY_SCOPE_AGENT); }
    static __device__ __forceinline__ float xld(const float* p) { return __hip_atomic_load(p, __ATOMIC_RELAXED, __HIP_MEMORY_SCOPE_AGENT); }
    static __device__ __forceinline__ float sum8x(const float* p) { float v[8];
#pragma unroll
        for (int i = 0; i < 8; ++i) v[i] = xld(p + i);
        return ((v[0] + v[1]) + (v[2] + v[3])) + ((v[4] + v[5]) + (v[6] + v[7])); }
    __device__ __forceinline__ void operator()(const f32x4 (&acc)[2][2][4][2], const Unit& u, int wr, int wc, int fr_, int fq_, int) const {
        int fr = fr_, fq = fq_; asm volatile("" : "+v"(fr), "+v"(fq));
        const int tid = (wr * 4 + wc) * 64 + fq * 16 + fr, slot = (wc * 4 + fq) * 256;
        PG8_LAS float* tab = red + 16 * 256; volatile PG8_LAS unsigned* flag = (volatile PG8_LAS unsigned*)(red + 17 * 256);
        const size_t prow = (size_t)u.pm * BM;
        const int col0 = u.pn * BM + wc * 32 + 8 * fq;
        u32x4 hq[2][4][2];
#pragma unroll
        for (int ai = 0; ai < 2; ++ai)
#pragma unroll
            for (int m = 0; m < 4; ++m) { const bf16_t* rp = H + (prow + ai * HALF + wr * 64 + m * 16 + fr) * 2048 + col0; hq[ai][m][0] = *(const u32x4*)rp; hq[ai][m][1] = *(const u32x4*)(rp + HALF); }
#pragma unroll
        for (int ai = 0; ai < 2; ++ai)
#pragma unroll
            for (int m = 0; m < 4; ++m) { float s_ = 0.f;
#pragma unroll
                for (int bj = 0; bj < 2; ++bj)
#pragma unroll
                    for (int n = 0; n < 2; ++n) { const f32x4 v = acc[ai][bj][m][n]; s_ += (v[0] * v[0] + v[1] * v[1]) + (v[2] * v[2] + v[3] * v[3]); }
                red[slot + ai * HALF + wr * 64 + m * 16 + fr] = s_; }
        asm volatile("s_waitcnt lgkmcnt(0)" ::: "memory"); __builtin_amdgcn_s_barrier();
        if (tid < 256) { xst(XP + (prow + tid) * 8 + u.pn, rowsum(tid)); asm volatile("s_waitcnt vmcnt(0)" ::: "memory"); }
        __builtin_amdgcn_s_barrier();
        if (tid == 0) { unsigned* c_ = cnt + u.pm; asm volatile("" : "+s"(c_));
            (void)xb_add(c_, 1u);
            { unsigned sp_ = 0; while (xb_ld(c_) < 8u) { __builtin_amdgcn_s_sleep(1); if ((++sp_ & 255u) == 0u) { if (xb_ld(tmo)) break; if (sp_ > (1u << 27)) { atomicAdd(tmo, 1u); break; } } } } }
        f32x4 gv[2][2];
#pragma unroll
        for (int bj = 0; bj < 2; ++bj) { gv[bj][0] = *(const f32x4*)(gy + col0 + bj * HALF); gv[bj][1] = *(const f32x4*)(gy + col0 + bj * HALF + 4); }
        asm volatile("s_waitcnt lgkmcnt(0)" ::: "memory"); __builtin_amdgcn_s_barrier();
        if (tid < 256) tab[tid] = 1.0f / sqrtf(sum8x(XP + (prow + tid) * 8) * (1.0f / 2048.0f) + 1e-6f);
        asm volatile("s_waitcnt lgkmcnt(0)" ::: "memory"); __builtin_amdgcn_s_barrier();
#pragma unroll
        for (int ai = 0; ai < 2; ++ai)
#pragma unroll
            for (int m = 0; m < 4; ++m) { const int rl = ai * HALF + wr * 64 + m * 16 + fr; const float rs = tab[rl]; bf16_t* rowp = H + (prow + rl) * 2048 + col0; float hs = 0.f;
#pragma unroll
                for (int bj = 0; bj < 2; ++bj) { const u32x4 hv = hq[ai][m][bj];
                    const f32x4 y0 = acc[ai][bj][m][0] * rs * gv[bj][0], y1 = acc[ai][bj][m][1] * rs * gv[bj][1];
                    float o[8];
                    o[0] = __builtin_bit_cast(float, hv.x << 16) + y0[0]; o[1] = __builtin_bit_cast(float, hv.x & 0xffff0000u) + y0[1]; o[2] = __builtin_bit_cast(float, hv.y << 16) + y0[2]; o[3] = __builtin_bit_cast(float, hv.y & 0xffff0000u) + y0[3];
                    o[4] = __builtin_bit_cast(float, hv.z << 16) + y1[0]; o[5] = __builtin_bit_cast(float, hv.z & 0xffff0000u) + y1[1]; o[6] = __builtin_bit_cast(float, hv.w << 16) + y1[2]; o[7] = __builtin_bit_cast(float, hv.w & 0xffff0000u) + y1[3];
#pragma unroll
                    for (int j = 0; j < 8; ++j) hs += o[j] * o[j];
                    if (FINAL) { float* op = OUT + (prow + rl) * 2048 + col0 + bj * HALF;
                        __builtin_nontemporal_store((f32x4){o[0], o[1], o[2], o[3]}, (f32x4*)op); __builtin_nontemporal_store((f32x4){o[4], o[5], o[6], o[7]}, (f32x4*)(op + 4)); }
                    else { u32x4 w; w.x = cvt_pk_bf16(o[0], o[1]); w.y = cvt_pk_bf16(o[2], o[3]); w.z = cvt_pk_bf16(o[4], o[5]); w.w = cvt_pk_bf16(o[6], o[7]);
                        *(u32x4*)(rowp + bj * HALF) = w; } }
                if (!FINAL) red[slot + rl] = hs; }
        if (FINAL) return;
        asm volatile("s_waitcnt lgkmcnt(0)" ::: "memory"); __builtin_amdgcn_s_barrier();
        if (tid < 256) { xst(XQ + (prow + tid) * 8 + u.pn, rowsum(tid)); asm volatile("s_waitcnt vmcnt(0)" ::: "memory"); }
        __builtin_amdgcn_s_barrier();
        if (tid == 0) { unsigned* c_ = cnt + 128 + u.pm; asm volatile("" : "+s"(c_));
            const unsigned old = xb_add(c_, 1u);
            flag[0] = old == 7u ? 1u : 0u; }
        asm volatile("s_waitcnt lgkmcnt(0)" ::: "memory"); __builtin_amdgcn_s_barrier();
        if (flag[0] != 0u && tid < 256) R2[prow + tid] = 1.0f / sqrtf(sum8x(XQ + (prow + tid) * 8) * (1.0f / 2048.0f) + 1e-6f);
        asm volatile("s_waitcnt lgkmcnt(0)" ::: "memory"); __builtin_amdgcn_s_barrier();
    }
};

template <class Epi, class Sched, bool ALIGN_EPI = false, bool SP2 = false>
__device__ __forceinline__ void gemm_phase(PG8_LAS unsigned char* lds, const Gemm g, const Sched& S, const Epi& E, const int tid) {
    const int wid = __builtin_amdgcn_readfirstlane(tid >> 6), lane = tid & 63, wr = wid >> 2, wc = wid & 3, fr = lane & 15, fq = lane >> 4;
    const int K = g.K, nt = K / BK;
    unsigned voffA[2], voffB[2];
#pragma unroll
    for (int i = 0; i < 2; ++i) { int R, C; stage_rc(tid * 16 + i * 8192, R, C); const int Rb = Epi::PERM ? ((R & ~31) + perm32(R & 31)) : R;
        voffA[i] = (unsigned)(R * K + C) * 2u; voffB[i] = (unsigned)(Rb * K + C) * 2u; }
    const size_t kstep = (size_t)(BK * 2);
    const size_t hstep = (size_t)HALF * K * 2;
    const size_t tstep = 2 * hstep;
    const unsigned ldsw = (unsigned)wid * 1024u;
    const int aoff = lds_byte(wr * 64 + fr, fq * 8), boff = lds_byte(wc * 32 + fr, fq * 8);
#define PG8_SA(b, h) (((b) * 2 + (h)) * HTB)
#define PG8_SB(b, h) ((4 + (b) * 2 + (h)) * HTB)
#define PG8_STAGE(bufoff, gbase, voff) do { _Pragma("unroll") for (int _i = 0; _i < 2; ++_i) \
        __builtin_amdgcn_global_load_lds((const unsigned*)((const char*)(gbase) + (voff)[_i]), (PG8_LAS unsigned*)(lds + (bufoff) + ldsw + _i * 8192), 16, 0, 0); } while (0)
#define PG8_LDA(dst, b, h) do { _Pragma("unroll") for (int m = 0; m < 4; ++m) _Pragma("unroll") for (int k = 0; k < 2; ++k) dst[m][k] = *(const PG8_LAS bf16x8*)(lds + PG8_SA(b, h) + aoff + m * 2048 + k * 1024); } while (0)
#define PG8_LDB(dst, b, h) do { _Pragma("unroll") for (int n = 0; n < 2; ++n) _Pragma("unroll") for (int k = 0; k < 2; ++k) dst[n][k] = *(const PG8_LAS bf16x8*)(lds + PG8_SB(b, h) + boff + n * 2048 + k * 1024); } while (0)
#define PG8_MMA(ai, bj, At, Bt) do { __builtin_amdgcn_s_setprio(1); _Pragma("unroll") for (int m = 0; m < 4; ++m) _Pragma("unroll") for (int n = 0; n < 2; ++n) _Pragma("unroll") for (int k = 0; k < 2; ++k) \
        acc[ai][bj][m][n] = __builtin_amdgcn_mfma_f32_16x16x32_bf16(Bt[n][k], At[m][k], acc[ai][bj][m][n], 0, 0, 0); __builtin_amdgcn_s_setprio(0); } while (0)
#define PG8_WAIT_V(n) asm volatile("s_waitcnt vmcnt(" #n ")" ::: "memory")
#define PG8_WAIT_L(n) asm volatile("s_waitcnt lgkmcnt(" #n ")" ::: "memory")
#define PG8_BAR __builtin_amdgcn_s_barrier()
#define PG8_SCHED __builtin_amdgcn_sched_barrier(0)
    Unit cur, nxt; int ui = 0;
    if (!S.next(0, cur)) return;
    f32x4 acc[2][2][4][2];
#pragma unroll
    for (int a = 0; a < 2; ++a)
#pragma unroll
        for (int b = 0; b < 2; ++b)
#pragma unroll
            for (int m = 0; m < 4; ++m)
#pragma unroll
                for (int n = 0; n < 2; ++n) acc[a][b][m][n] = (f32x4){0.f, 0.f, 0.f, 0.f};
    bf16x8 At[4][2], B0[2][2], B1[2][2];
    const char* cA = (const char*)g.A + (size_t)cur.pm * tstep; const char* cB = (const char*)g.Bt + (size_t)cur.pn * tstep;
    S.a_ready(cur);
    if constexpr (Epi::HAS_SCALE) E.prefetch(cur, 0, wid, lane);
    if constexpr (SP2) {
        PG8_STAGE(PG8_SB(0, 0), cB, voffB); PG8_STAGE(PG8_SB(0, 1), cB + hstep, voffB); PG8_STAGE(PG8_SA(0, 0), cA, voffA); PG8_STAGE(PG8_SA(0, 1), cA + hstep, voffA);
        if (wr == 1) PG8_BAR;
        PG8_WAIT_V(2); PG8_BAR;
        PG8_STAGE(PG8_SB(1, 0), cB + kstep, voffB); PG8_STAGE(PG8_SA(1, 0), cA + kstep, voffA); PG8_STAGE(PG8_SB(1, 1), cB + hstep + kstep, voffB);
        PG8_WAIT_V(6); PG8_BAR;
    } else {
        PG8_STAGE(PG8_SB(0, 0), cB, voffB); PG8_STAGE(PG8_SA(0, 0), cA, voffA); PG8_STAGE(PG8_SB(0, 1), cB + hstep, voffB); PG8_STAGE(PG8_SA(0, 1), cA + hstep, voffA);
        if (wr == 1) PG8_BAR;
        PG8_WAIT_V(4); PG8_BAR;
        PG8_STAGE(PG8_SB(1, 0), cB + kstep, voffB); PG8_STAGE(PG8_SA(1, 0), cA + kstep, voffA); PG8_STAGE(PG8_SB(1, 1), cB + hstep + kstep, voffB);
        PG8_WAIT_V(6); PG8_BAR;
    }
    for (;;) {
        const bool has_next = S.next(ui + 1, nxt);
        const char* nA = has_next ? (const char*)g.A + (size_t)nxt.pm * tstep : cA; const char* nB = has_next ? (const char*)g.Bt + (size_t)nxt.pn * tstep : cB;
        for (int t = 0; t < nt; t += 2) {
            const bool last = (t == nt - 2);
            const char* a1 = cA + (size_t)(t + 1) * kstep;
            const char* a2 = last ? nA : cA + (size_t)(t + 2) * kstep; const char* b2 = last ? nB : cB + (size_t)(t + 2) * kstep;
            const char* a3 = a2 + kstep; const char* b3 = b2 + kstep;
            if (last && has_next) { S.a_ready(nxt); if constexpr (Epi::HAS_SCALE) E.prefetch(nxt, (ui + 1) & 1, wid, lane); }
            if constexpr (SP2) {
            PG8_LDB(B0, 0, 0); PG8_LDB(B1, 0, 1); PG8_SCHED; PG8_LDA(At, 0, 0); PG8_STAGE(PG8_SA(1, 1), a1 + hstep, voffA);
            PG8_WAIT_V(8); PG8_WAIT_L(0); PG8_BAR; PG8_MMA(0, 0, At, B0); PG8_MMA(0, 1, At, B1); PG8_BAR; PG8_SCHED;
            PG8_LDA(At, 0, 1); PG8_STAGE(PG8_SB(0, 0), b2, voffB); PG8_STAGE(PG8_SB(0, 1), b2 + hstep, voffB); PG8_STAGE(PG8_SA(0, 0), a2, voffA);
            PG8_WAIT_V(8); PG8_WAIT_L(0); PG8_BAR; PG8_MMA(1, 0, At, B0); PG8_MMA(1, 1, At, B1); PG8_BAR; PG8_SCHED;
            PG8_LDB(B0, 1, 0); PG8_LDB(B1, 1, 1); PG8_SCHED; PG8_LDA(At, 1, 0); PG8_STAGE(PG8_SA(0, 1), a2 + hstep, voffA);
            PG8_WAIT_V(8); PG8_WAIT_L(0); PG8_BAR; PG8_MMA(0, 0, At, B0); PG8_MMA(0, 1, At, B1); PG8_BAR; PG8_SCHED;
            PG8_LDA(At, 1, 1); PG8_STAGE(PG8_SB(1, 0), b3, voffB); PG8_STAGE(PG8_SB(1, 1), b3 + hstep, voffB); PG8_STAGE(PG8_SA(1, 0), a3, voffA);
            PG8_WAIT_V(8); PG8_WAIT_L(0); PG8_BAR; PG8_MMA(1, 0, At, B0); PG8_MMA(1, 1, At, B1); PG8_BAR; PG8_SCHED;
            } else {
            PG8_LDB(B0, 0, 0); PG8_SCHED; PG8_LDA(At, 0, 0); PG8_STAGE(PG8_SA(1, 1), a1 + hstep, voffA);
            PG8_WAIT_L(8); PG8_BAR; PG8_WAIT_L(0); PG8_MMA(0, 0, At, B0); PG8_BAR; PG8_SCHED;
            PG8_LDB(B1, 0, 1); PG8_STAGE(PG8_SB(0, 0), b2, voffB);
            PG8_BAR; PG8_WAIT_L(0); PG8_MMA(0, 1, At, B1); PG8_BAR;
            PG8_LDA(At, 0, 1); PG8_STAGE(PG8_SA(0, 0), a2, voffA);
            PG8_BAR; PG8_WAIT_L(0); PG8_MMA(1, 0, At, B0); PG8_BAR; PG8_SCHED;
            PG8_STAGE(PG8_SB(0, 1), b2 + hstep, voffB);
            PG8_WAIT_V(6); PG8_BAR; PG8_MMA(1, 1, At, B1); PG8_BAR;
            PG8_LDB(B0, 1, 0); PG8_SCHED; PG8_LDA(At, 1, 0); PG8_STAGE(PG8_SA(0, 1), a2 + hstep, voffA);
            PG8_WAIT_L(8); PG8_BAR; PG8_WAIT_L(0); PG8_MMA(0, 0, At, B0); PG8_BAR; PG8_SCHED;
            PG8_LDB(B1, 1, 1); PG8_STAGE(PG8_SB(1, 0), b3, voffB);
            PG8_BAR; PG8_WAIT_L(0); PG8_MMA(0, 1, At, B1); PG8_BAR;
            PG8_LDA(At, 1, 1); PG8_STAGE(PG8_SA(1, 0), a3, voffA);
            PG8_BAR; PG8_WAIT_L(0); PG8_MMA(1, 0, At, B0); PG8_BAR; PG8_SCHED;
            PG8_STAGE(PG8_SB(1, 1), b3 + hstep, voffB);
            PG8_WAIT_V(6); PG8_BAR; PG8_MMA(1, 1, At, B1); PG8_BAR;
            }
        }
        if constexpr (ALIGN_EPI) { if (wr == 0) PG8_BAR; }
        if constexpr (!Epi::AFTER_DRAIN) { E(acc, cur, wr, wc, fr, fq, ui & 1); S.done(cur); }
        if (!has_next) break;
#pragma unroll
        for (int a = 0; a < 2; ++a)
#pragma unroll
            for (int b = 0; b < 2; ++b)
#pragma unroll
                for (int m = 0; m < 4; ++m)
#pragma unroll
                    for (int n = 0; n < 2; ++n) acc[a][b][m][n] = (f32x4){0.f, 0.f, 0.f, 0.f};
        cur = nxt; cA = nA; cB = nB; ++ui;
        if constexpr (ALIGN_EPI) { if (wr == 1) PG8_BAR; }
    }
    PG8_WAIT_V(0);
    if constexpr (!ALIGN_EPI) { if (wr == 0) PG8_BAR; }
    PG8_BAR;
#undef PG8_SA
#undef PG8_SB
#undef PG8_STAGE
#undef PG8_LDA
#undef PG8_LDB
#undef PG8_MMA
#undef PG8_WAIT_V
#undef PG8_WAIT_L
#undef PG8_BAR
#undef PG8_SCHED
}
}

#define XB_TMO      128
#define XB_XCNT(j)  (256  + 64 * (j))
#define XB_XSUB(j)  (1280 + 64 * (j))
#define XB_XGEN(j)  (2304 + 64 * (j))
#define XB_TOP      3328
#define XB_TOPGEN   3392
#define XCD_BAR_WORDS 3456
#define XB_SPIN_CAP (1u << 27)
__device__ __forceinline__ unsigned xb_ld(unsigned* p)              { return __hip_atomic_load(p, __ATOMIC_RELAXED, __HIP_MEMORY_SCOPE_AGENT); }
__device__ __forceinline__ unsigned xb_add(unsigned* p, unsigned v) { return __hip_atomic_fetch_add(p, v, __ATOMIC_RELAXED, __HIP_MEMORY_SCOPE_AGENT); }
__device__ __forceinline__ unsigned xb_xcc_id() { return (unsigned)__builtin_amdgcn_s_getreg((3 << 11) | 20) & 0xFu; }
#define XB_SPIN(cond, bar) do { unsigned _sp = 0; while (cond) { __builtin_amdgcn_s_sleep(1); \
    if ((++_sp & 255u) == 0u) { if (xb_ld(&(bar)[XB_TMO])) break; if (_sp > XB_SPIN_CAP) { atomicAdd(&(bar)[XB_TMO], 1u); break; } } } } while (0)
struct XcdBarrier { unsigned* bar; unsigned x; volatile LAS unsigned* st; };
__device__ __forceinline__ XcdBarrier xcd_barrier_post(unsigned* bar, volatile LAS unsigned* st) {
    XcdBarrier b; b.bar = bar; b.x = xb_xcc_id(); b.st = st;
    if (threadIdx.x == 0) (void)xb_add(&bar[XB_XCNT(b.x)], 1u);
    return b;
}
__device__ __forceinline__ void xcd_barrier_complete(unsigned* bar, unsigned x, unsigned& nloc, unsigned& nx) {
    const unsigned G = gridDim.x * gridDim.y * gridDim.z;
    unsigned sum, cnt, mine, sp = 0u;
    for (;;) {
        sum = 0u; cnt = 0u; mine = 0u;
#pragma unroll
        for (unsigned j = 0; j < 16; ++j) { const unsigned c = xb_ld(&bar[XB_XCNT(j)]); sum += c; cnt += (c > 0u) ? 1u : 0u; mine = (j == x) ? c : mine; }
        if (sum == G) break;
        __builtin_amdgcn_s_sleep(1);
        if ((++sp & 255u) == 0u) { if (xb_ld(&bar[XB_TMO])) break; if (sp > XB_SPIN_CAP) { atomicAdd(&bar[XB_TMO], 1u); break; } }
    }
    nloc = mine > 0u ? mine : 1u; nx = cnt > 0u ? cnt : 1u;
}
__device__ __forceinline__ void xcd_barrier(const XcdBarrier& b) {
    asm volatile("s_waitcnt vmcnt(0)" ::: "memory");
    __syncthreads();
    if (threadIdx.x == 0) {
        unsigned* bar = b.bar; asm volatile("" : "+s"(bar));
        __builtin_amdgcn_s_waitcnt(0);
        unsigned nloc = b.st[0], nx = b.st[1];
        if (nloc == 0u) { xcd_barrier_complete(bar, b.x, nloc, nx); b.st[0] = nloc; b.st[1] = nx; }
        const unsigned old = xb_add(&bar[XB_XSUB(b.x)], 1u);
        const unsigned gen = old / nloc;
        if (old + 1u == (gen + 1u) * nloc) {
            __builtin_amdgcn_fence(__ATOMIC_RELEASE, "agent");
            asm volatile("s_waitcnt vmcnt(0)" ::: "memory");
            const unsigned og = xb_add(&bar[XB_TOP], 1u);
            const unsigned tg = og / nx;
            if (og + 1u == (tg + 1u) * nx) xb_add(&bar[XB_TOPGEN], 1u);
            else XB_SPIN(xb_ld(&bar[XB_TOPGEN]) == tg, bar);
            __builtin_amdgcn_fence(__ATOMIC_ACQUIRE, "agent");
            xb_add(&bar[XB_XGEN(b.x)], 1u);
            asm volatile("s_waitcnt vmcnt(0)" ::: "memory");
        } else {
            XB_SPIN(xb_ld(&bar[XB_XGEN(b.x)]) == gen, bar);
            __builtin_amdgcn_fence(__ATOMIC_ACQUIRE, "agent");
            asm volatile("s_waitcnt vmcnt(0)" ::: "memory");
        }
    }
    __syncthreads();
}

#ifndef SIMPLE_GEMM
#define SIMPLE_GEMM 0
#endif
#ifndef MK_N_LAUNCHES
#define MK_N_LAUNCHES 1
#endif
constexpr int N_PHASES = 8 * kL + 1;
constexpr int RING_BYTES = 131072, LDS_BYTES = 163840, MISC_OFF = LDS_BYTES - 256;
static_assert(3 * CL_BYTES <= MISC_OFF && SL_END <= MISC_OFF && PL_END <= MISC_OFF, "lds map");
constexpr int CW_BAR = 4096;
constexpr int CW_CNT = CW_BAR + XCD_BAR_WORDS, CNT_WORDS = 2 * kL * 256;
#ifndef FUSE_NORM
#define FUSE_NORM 1
#endif
__global__ void __launch_bounds__(512, 2) fwd_kernel(Args args) {
    extern __shared__ __attribute__((aligned(16))) unsigned char lds[];
    Frame F;
    F.lds = (LAS unsigned char*)lds;
    F.tid = threadIdx.x; F.lane = F.tid & 63; F.wave = __builtin_amdgcn_readfirstlane(F.tid >> 6); F.G = gridDim.x; F.bid = blockIdx.x;
    int wave_s = F.wave; asm volatile("" : "+s"(wave_s));
    F.ka = ka_fresh();
    unsigned char* ws = args.ws;
    volatile LAS unsigned* MISC = (volatile LAS unsigned*)(F.lds + MISC_OFF);
    if (F.tid < 32) MISC[F.tid] = 0u;
    __syncthreads();
    const int lo = args.ph_lo, hi = args.ph_hi;
    XcdBarrier bar; bar.bar = (unsigned*)(ws + WS_CTL) + CW_BAR; bar.x = 0; bar.st = nullptr;
    if (hi - lo > 1) bar = xcd_barrier_post((unsigned*)(ws + WS_CTL) + CW_BAR, MISC + 8);
#ifndef PHMASK
#define PHMASK 0xFFFF
#endif
#define IN(p) (lo <= (p) && (p) < hi)
#define PHASE_BEGIN() do { F.ka = ka_fresh(); int tz_; asm volatile("v_mbcnt_lo_u32_b32 %0, -1, 0\n\tv_mbcnt_hi_u32_b32 %0, -1, %0" : "=v"(tz_)); tz_ += wave_s * 64; F.tid = tz_; F.lane = tz_ & 63; F.wave = __builtin_amdgcn_readfirstlane(tz_ >> 6); } while (0)
#define EN(k) ((PHMASK >> (k)) & 1)
#ifndef REPMASK
#define REPMASK 0
#endif
#define REP(k) (1 + ((REPMASK >> (k)) & 1))
#define SEAM(p) do { if (IN(p) && IN((p) + 1)) xcd_barrier(bar); else __syncthreads(); } while (0)
#pragma unroll 1
    for (int l = 0; l < kL; ++l) {
        const int p0 = 8 * l;
        if (IN(p0)) { PHASE_BEGIN();
            if (EN(0)) { if (l == 0) { init_phase(F); norm_phase<0>(F, nullptr, 4);
                if (F.wave >= 4) for (int it = F.bid * 4 + (F.wave - 4); it < CV_N0 + CV_N1; it += F.G * 4) conv_wave_tile(F, 0, it, F.lane); }
            else if (!FUSE_NORM) norm_phase<1>(F, F.in(I_NQF) + (l - 1) * kD); }
        }
        if (l == 0 || !FUSE_NORM) SEAM(p0);
        if (EN(2) && IN(p0 + 1) && (SIMPLE_GEMM & 1)) { PHASE_BEGIN(); simple_gemm_phase<0>(F, F.HB(), F.WinT(l), kM, kNP, kD, F.P(), kNP); }
        else if (EN(2) && IN(p0 + 1)) { PHASE_BEGIN(); pg8::Gemm g{F.HB(), F.WinT(l), kM, kNP, kD}; pg8::StaticOrder S; S.init(kM, kNP, F.G, F.bid); pg8::EpiBf16<true> E{F.P(), kNP, F.R2(), (LAS float*)(F.lds + RING_BYTES)};
            pg8::gemm_phase<pg8::EpiBf16<true>, pg8::StaticOrder, true, true>(F.lds, g, S, E, F.tid); }
        SEAM(p0 + 1);
        for (int rep_ = 0; rep_ < REP(3); ++rep_) { if (EN(3) && IN(p0 + 2)) { PHASE_BEGIN(); prep_phase(F, l); } }
        SEAM(p0 + 2);
        for (int rep_ = 0; rep_ < REP(4); ++rep_) { if (EN(4) && IN(p0 + 3)) { PHASE_BEGIN(); mix_phase(F, l); } }
        SEAM(p0 + 3);
        if (EN(5) && IN(p0 + 4) && (SIMPLE_GEMM & 2)) { PHASE_BEGIN(); simple_gemm_phase<0>(F, F.O(), F.WoutT(l), kM, kD, kD, F.Y(), kD); }
        else if (EN(5) && IN(p0 + 4) && FUSE_NORM) { PHASE_BEGIN(); pg8::Gemm g{F.O(), F.WoutT(l), kM, kD, kD}; pg8::PanelOrder S; S.init(kM, F.G, F.bid);
            float* xp = (float*)(F.ws() + WS_Y + 160 * MiB); unsigned* ctl = (unsigned*)(F.ws() + WS_CTL);
            pg8::EpiResNorm<false> E{nullptr, F.HB(), F.in(I_NQM) + l * kD, xp, xp + (size_t)kM * 8, F.R2(), ctl + CW_CNT + (2 * l) * 256, ctl + CW_BAR + XB_TMO, (LAS float*)(F.lds + RING_BYTES)};
            pg8::gemm_phase<pg8::EpiResNorm<false>, pg8::PanelOrder, true, true>(F.lds, g, S, E, F.tid); }
        else if (EN(5) && IN(p0 + 4)) { PHASE_BEGIN(); pg8::Gemm g{F.O(), F.WoutT(l), kM, kD, kD}; pg8::StaticOrder S; S.init(kM, kD, F.G, F.bid); pg8::EpiBf16<false> E{F.Y(), kD, nullptr, nullptr};
            pg8::gemm_phase<pg8::EpiBf16<false>, pg8::StaticOrder, true, true>(F.lds, g, S, E, F.tid); }
        SEAM(p0 + 4);
        if (!FUSE_NORM) { if (EN(6) && IN(p0 + 5)) { PHASE_BEGIN(); norm_phase<1>(F, F.in(I_NQM) + l * kD); }
        SEAM(p0 + 5); }
        if (EN(7) && IN(p0 + 6) && (SIMPLE_GEMM & 4)) { PHASE_BEGIN(); simple_gemm_phase<1>(F, F.HB(), F.WguT(l), kM, 2 * kFF, kD, F.P(), kFF); }
        else if (EN(7) && IN(p0 + 6)) { PHASE_BEGIN(); pg8::Gemm g{F.HB(), F.WguT(l), kM, 2 * kFF, kD}; pg8::StaticOrder S; S.init(kM, 2 * kFF, F.G, F.bid); pg8::EpiSwiGlu E{F.P(), kFF, F.R2(), (LAS float*)(F.lds + RING_BYTES)};
            pg8::gemm_phase<pg8::EpiSwiGlu, pg8::StaticOrder, true, true>(F.lds, g, S, E, F.tid); }
        SEAM(p0 + 6);
        if (EN(8) && IN(p0 + 7) && (SIMPLE_GEMM & 8)) { PHASE_BEGIN(); simple_gemm_phase<0>(F, F.P(), F.WdT(l), kM, kD, kFF, F.Y(), kD); }
        else if (EN(8) && IN(p0 + 7) && FUSE_NORM && l + 1 < kL) { PHASE_BEGIN(); pg8::Gemm g{F.P(), F.WdT(l), kM, kD, kFF}; pg8::PanelOrder S; S.init(kM, F.G, F.bid);
            float* xp = (float*)(F.ws() + WS_Y + 160 * MiB); unsigned* ctl = (unsigned*)(F.ws() + WS_CTL);
            pg8::EpiResNorm<false> E{nullptr, F.HB(), F.in(I_NQF) + l * kD, xp, xp + (size_t)kM * 8, F.R2(), ctl + CW_CNT + (2 * l + 1) * 256, ctl + CW_BAR + XB_TMO, (LAS float*)(F.lds + RING_BYTES)};
            pg8::gemm_phase<pg8::EpiResNorm<false>, pg8::PanelOrder, true, true>(F.lds, g, S, E, F.tid); }
        else if (EN(8) && IN(p0 + 7) && FUSE_NORM) { PHASE_BEGIN(); pg8::Gemm g{F.P(), F.WdT(l), kM, kD, kFF}; pg8::PanelOrder S; S.init(kM, F.G, F.bid);
            float* xp = (float*)(F.ws() + WS_Y + 160 * MiB); unsigned* ctl = (unsigned*)(F.ws() + WS_CTL);
            pg8::EpiResNorm<true> E{F.out(), F.HB(), F.in(I_NQF) + l * kD, xp, xp + (size_t)kM * 8, F.R2(), ctl + CW_CNT + (2 * l + 1) * 256, ctl + CW_BAR + XB_TMO, (LAS float*)(F.lds + RING_BYTES)};
            pg8::gemm_phase<pg8::EpiResNorm<true>, pg8::PanelOrder, true, true>(F.lds, g, S, E, F.tid); }
        else if (EN(8) && IN(p0 + 7)) { PHASE_BEGIN(); pg8::Gemm g{F.P(), F.WdT(l), kM, kD, kFF}; pg8::StaticOrder S; S.init(kM, kD, F.G, F.bid); pg8::EpiBf16<false> E{F.Y(), kD, nullptr, nullptr};
            pg8::gemm_phase<pg8::EpiBf16<false>, pg8::StaticOrder, true, true>(F.lds, g, S, E, F.tid); }
        if (!FUSE_NORM || l + 1 < kL) SEAM(p0 + 7);
    }
    if (!FUSE_NORM && IN(8 * kL)) { PHASE_BEGIN(); norm_phase<2>(F, F.in(I_NQF) + (kL - 1) * kD); }
#undef IN
#undef SEAM
}

extern "C" void kernel_launch(void* const* d_in, const int* in_sizes, int n_in, void* d_out, int out_size, void* d_ws, size_t ws_size, hipStream_t stream) {
    static int grid = 0;
    if (grid == 0) {
        if (n_in != 31 || out_size != kM * kD || ws_size < WS_END) { fprintf(stderr, "kernel_launch: unexpected shapes (n_in %d out %d ws %zu need %zu)\n", n_in, out_size, ws_size, (size_t)WS_END); grid = -1; return; }
        int dev = 0, cus = 0, per_cu = 0;
        if (hipGetDevice(&dev) != hipSuccess || hipDeviceGetAttribute(&cus, hipDeviceAttributeMultiprocessorCount, dev) != hipSuccess) { grid = -1; return; }
        if (hipFuncSetAttribute((const void*)fwd_kernel, hipFuncAttributeMaxDynamicSharedMemorySize, LDS_BYTES) != hipSuccess) { fprintf(stderr, "kernel_launch: hipFuncSetAttribute failed\n"); grid = -1; return; }
        if (hipOccupancyMaxActiveBlocksPerMultiprocessor(&per_cu, (const void*)fwd_kernel, 512, LDS_BYTES) != hipSuccess || per_cu < 1) { fprintf(stderr, "kernel_launch: occupancy query says %d\n", per_cu); }
        (void)hipGetLastError();
        grid = cus;
    }
    if (grid < 0) return;
    (void)hipMemsetAsync((char*)d_ws + WS_CTL + (size_t)CW_BAR * 4, 0, (size_t)(XCD_BAR_WORDS + CNT_WORDS) * 4, stream);
    Args a{};
    for (int i = 0; i < 31; ++i) a.in[i] = (const float*)d_in[i];
    a.out = (float*)d_out; a.ws = (unsigned char*)d_ws;
    constexpr int NL = MK_N_LAUNCHES;
    for (int li = 0; li < NL; ++li) {
        a.ph_lo = (int)((long)N_PHASES * li / NL); a.ph_hi = (int)((long)N_PHASES * (li + 1) / NL);
        hipLaunchKernelGGL(fwd_kernel, dim3(grid), dim3(512), LDS_BYTES, stream, a);
    }
}
#endif
```

```cpp
#ifndef HOST_EMU
#include <hip/hip_runtime.h>
#include <cstdio>
#include <cstdint>
#endif

#ifndef BATCH
#define BATCH 16
#endif
#ifndef SEQ
#define SEQ 2048
#endif
constexpr int kB = BATCH, kS = SEQ, kM = kB * kS, kD = 2048, kL = 4, kG = 512, kH = 8, kHD = 64, kFF = 5632;
constexpr int kNIN = 7952, kNP = 8192;
constexpr int PC_RET = 0, PC_HG = 2048, PC_ML = 4096, PC_RW = 6144, PC_MLG = 7936;
constexpr int kRWS = 3584;
constexpr int RS_R = 0, RS_W = 512, RS_K = 1024, RS_V = 1536, RS_KK = 2048, RS_B = 2560, RS_G = 3072;
constexpr float kNormEps = 1e-6f, kRwkvLnEps = 64e-5f, kDecayScale = 0.6065306597126334f;

typedef unsigned short u16;
typedef short bf16x8 __attribute__((ext_vector_type(8)));
typedef float f32x4 __attribute__((ext_vector_type(4)));
typedef unsigned u32x4 __attribute__((ext_vector_type(4)));
typedef unsigned u32x2 __attribute__((ext_vector_type(2)));

#ifndef HOST_EMU
#define DEV __device__ __forceinline__
#define MDEV __device__ __forceinline__
#define LAS __attribute__((address_space(3)))
DEV f32x4 mfma16(bf16x8 a, bf16x8 b, f32x4 c) { return __builtin_amdgcn_mfma_f32_16x16x32_bf16(a, b, c, 0, 0, 0); }
template <int CTRL> DEV float dppf(float x) { return __builtin_bit_cast(float, __builtin_amdgcn_mov_dpp(__builtin_bit_cast(int, x), CTRL, 0xf, 0xf, true)); }
DEV float lx1(float x) { return dppf<0xB1>(x); }
DEV float lx2(float x) { return dppf<0x4E>(x); }
DEV float lm8(float x) { return dppf<0x141>(x); }
DEV float lr8(float x) { return dppf<0x128>(x); }
template <int CTRL, int RM> DEV float dppz(float x) { return __builtin_bit_cast(float, __builtin_amdgcn_update_dpp(0, __builtin_bit_cast(int, x), CTRL, RM, 0xf, true)); }
DEV float scan32(float v) { v += dppz<0x111, 0xf>(v); v += dppz<0x112, 0xf>(v); v += dppz<0x114, 0xf>(v); v += dppz<0x118, 0xf>(v); v += dppz<0x142, 0xa>(v); return v; }
DEV float xswap32(float x, bool lower) { auto t = __builtin_amdgcn_permlane32_swap(__builtin_bit_cast(unsigned, x), __builtin_bit_cast(unsigned, x), false, false); return __builtin_bit_cast(float, lower ? t[1] : t[0]); }
DEV float lxany(float x, int lane, int m) { return __builtin_bit_cast(float, __builtin_amdgcn_ds_bpermute((lane ^ m) << 2, __builtin_bit_cast(int, x))); }
DEV float rdlane(float x, int i) { return __builtin_bit_cast(float, __builtin_amdgcn_readlane(__builtin_bit_cast(int, x), i)); }
DEV void wave_sync() { asm volatile("s_waitcnt lgkmcnt(0)" ::: "memory"); __builtin_amdgcn_wave_barrier(); }
DEV void wait_vm0() { asm volatile("s_waitcnt vmcnt(0)" ::: "memory"); }
DEV void lds_sync() { asm volatile("s_waitcnt lgkmcnt(0)" ::: "memory"); __builtin_amdgcn_s_barrier(); }
DEV void glds16(const u16* g, LAS u16* lbase, int) { __builtin_amdgcn_global_load_lds((const unsigned*)g, (LAS unsigned*)lbase, 16, 0, 2); }
typedef float f32x2_ __attribute__((ext_vector_type(2)));
typedef __bf16 bf16x2_ __attribute__((ext_vector_type(2)));
DEV unsigned cvtpk(float lo, float hi) { const f32x2_ v = {lo, hi}; return __builtin_bit_cast(unsigned, __builtin_convertvector(v, bf16x2_)); }
DEV float fexp(float x) { return __expf(x); }
DEV float frcp(float x) { return __builtin_amdgcn_rcpf(x); }
DEV float frsq(float x) { return __builtin_amdgcn_rsqf(x); }
DEV float sin_rev(float fr) { return __builtin_amdgcn_sinf(fr); }
DEV float cos_rev(float fr) { return __builtin_amdgcn_cosf(fr); }
#endif

DEV float sum8(float x) { x += lx1(x); x += lx2(x); x += lm8(x); return x; }
DEV float sum16(float x) { x = sum8(x); x += lr8(x); return x; }
DEV float sum64(float v) { const float r = sum16(v); return (rdlane(r, 0) + rdlane(r, 16)) + (rdlane(r, 32) + rdlane(r, 48)); }

DEV u16 f2bf(float f) { unsigned u = __builtin_bit_cast(unsigned, f); return (u16)((u + 0x7fffu + ((u >> 16) & 1u)) >> 16); }
DEV float bf2f(u16 b) { return __builtin_bit_cast(float, ((unsigned)b) << 16); }
DEV unsigned pk2(float lo, float hi) { return (unsigned)f2bf(lo) | ((unsigned)f2bf(hi) << 16); }
DEV float sigm(float x) { return 1.0f / (1.0f + expf(-x)); }
DEV float fsig(float x) { return frcp(1.0f + fexp(-x)); }
DEV float logsig(float x) { return fminf(x, 0.f) - log1pf(expf(-fabsf(x))); }
DEV void unpack8(u32x4 v, float* o) {
    o[0] = bf2f((u16)(v.x & 0xffff)); o[1] = bf2f((u16)(v.x >> 16)); o[2] = bf2f((u16)(v.y & 0xffff)); o[3] = bf2f((u16)(v.y >> 16));
    o[4] = bf2f((u16)(v.z & 0xffff)); o[5] = bf2f((u16)(v.z >> 16)); o[6] = bf2f((u16)(v.w & 0xffff)); o[7] = bf2f((u16)(v.w >> 16));
}
DEV u32x4 pack8(const float* o) { u32x4 v; v.x = pk2(o[0], o[1]); v.y = pk2(o[2], o[3]); v.z = pk2(o[4], o[5]); v.w = pk2(o[6], o[7]); return v; }

constexpr size_t MiB = 1u << 20;
constexpr size_t al1m(size_t x) { return (x + MiB - 1) / MiB * MiB; }
constexpr size_t WS_CTL = 0, CTL_ZERO_BYTES = 1 * MiB;
constexpr size_t WS_TRIG = 1 * MiB;
constexpr size_t WS_R2 = 1 * MiB + 512 * 1024;
constexpr size_t WS_SW = 2 * MiB;
constexpr int SW_WUP = 0, SW_AUP = 512 * 64, SW_GUP = 2 * 512 * 64, SW_VDN = SW_GUP + 512 * 128, SW_VUP = SW_VDN + 32 * 512, SW_LAYER = SW_VUP + 512 * 32;
constexpr size_t WS_W = 4 * MiB;
constexpr size_t WO_IN = 0, WO_OUT = (size_t)kNP * kD * 2, WO_GU = WO_OUT + (size_t)kD * kD * 2, WO_DN = WO_GU + (size_t)2 * kFF * kD * 2, WO_END = WO_DN + (size_t)kD * kFF * 2;
constexpr size_t WS_U = WS_W + al1m(WO_END);
constexpr size_t WS_P = WS_U + al1m((size_t)kM * kD * 2);
constexpr size_t WS_Y = WS_P + al1m((size_t)kM * kNP * 2);
constexpr size_t WS_VF = WS_Y + al1m((size_t)kM * kRWS * 2);
constexpr size_t WS_END = WS_VF + al1m((size_t)kM * kG * 2);

struct Args { const float* in[31]; float* out; unsigned char* ws; int ph_lo, ph_hi; };
#ifndef HOST_EMU
typedef const __attribute__((address_space(4))) Args* KArgs;
DEV KArgs ka_fresh() { KArgs p = (KArgs)__builtin_amdgcn_kernarg_segment_ptr(); asm volatile("" : "+s"(p)); return p; }
#else
typedef const Args* KArgs;
#endif
struct Frame {
    LAS unsigned char* lds;
    int tid, lane, wave, G, bid;
    KArgs ka;
    MDEV const float* in(int i) const { return ka->in[i]; }
    MDEV float* out() const { return ka->out; }
    MDEV unsigned char* ws() const { return ka->ws; }
    MDEV u16* HB() const { return (u16*)(ws() + WS_U); }
    MDEV u16* O() const { return (u16*)out(); }
    MDEV float* R2() const { return (float*)(ws() + WS_R2); }
    MDEV u16* P() const { return (u16*)(ws() + WS_P); }
    MDEV u16* Y() const { return (u16*)(ws() + WS_Y); }
    MDEV u16* RWS() const { return (u16*)(ws() + WS_Y); }
    MDEV u16* VF() const { return (u16*)(ws() + WS_VF); }
    MDEV unsigned char* wbase(int l) const { return (l & 1) ? ws() + WS_W : (unsigned char*)out() + (size_t)kM * kD * 2; }
    MDEV u16* WinT(int l) const { return (u16*)(wbase(l) + WO_IN); }
    MDEV u16* WoutT(int l) const { return (u16*)(wbase(l) + WO_OUT); }
    MDEV u16* WguT(int l) const { return (u16*)(wbase(l) + WO_GU); }
    MDEV u16* WdT(int l) const { return (u16*)(wbase(l) + WO_DN); }
    MDEV u16* SW() const { return (u16*)(ws() + WS_SW); }
    MDEV float* TRIG() const { return (float*)(ws() + WS_TRIG); }
};
enum { I_X = 0, I_WIN, I_WOUT, I_NPM, I_NQM, I_NPF, I_NQF, I_WG, I_WU, I_WD, I_HLB, I_HNW, I_MCW, I_MCB, I_MIB, I_MFB, I_MNW, I_MU, I_W0, I_WUP, I_A0, I_AUP, I_GUP, I_KK, I_KA, I_RK, I_LNW, I_LNB, I_V0, I_VDN, I_VUP };

DEV void init_phase(Frame& F) {
    const int gt = F.bid * 512 + F.tid, NT = F.G * 512;
    for (int i = gt; i < kS * 32; i += NT) {
        const int pos = i >> 5, j = i & 31;
        const float invf = powf(10000.0f, -(float)j / 32.0f);
        const float ang = (float)pos * invf;
        const double rev = (double)ang * 0.15915494309189535;
        const float fr = (float)(rev - floor(rev));
        F.TRIG()[2 * i] = cos_rev(fr); F.TRIG()[2 * i + 1] = sin_rev(fr);
    }
    for (int i = gt; i < kL * SW_LAYER; i += NT) {
        const int l = i / SW_LAYER, r = i % SW_LAYER; float v;
        if (r < SW_AUP) { const int n = r / 64, k = r % 64; v = F.in(I_WUP)[((size_t)l * 64 + k) * 512 + n]; }
        else if (r < SW_GUP) { const int q = r - SW_AUP, n = q / 64, k = q % 64; v = F.in(I_AUP)[((size_t)l * 64 + k) * 512 + n]; }
        else if (r < SW_VDN) { const int q = r - SW_GUP, n = q / 128, k = q % 128; v = F.in(I_GUP)[((size_t)l * 128 + k) * 512 + n]; }
        else if (r < SW_VUP) { const int q = r - SW_VDN, n = q / 512, k = q % 512; v = l > 0 ? F.in(I_VDN)[((size_t)(l - 1) * 512 + k) * 32 + n] : 0.f; }
        else { const int q = r - SW_VUP, n = q / 32, k = q % 32; v = l > 0 ? F.in(I_VUP)[((size_t)(l - 1) * 32 + k) * 512 + n] : 0.f; }
        F.SW()[i] = f2bf(v);
    }
}

DEV void conv_item(Frame& F, int l, int mat, int nb, int kb) {
    LAS float* tile = (LAS float*)F.lds;
    const int nn = F.tid & 63, k8 = F.tid >> 6;
    const int n = nb * 64 + nn;
    const float* src; int ld, sc; bool ok = true; int K; const float* gk = nullptr;
    if (mat == 0) { K = kD; ld = kNIN; src = F.in(I_WIN) + (size_t)l * kD * kNIN; gk = F.in(I_NPM) + l * kD;
        if (n < PC_RW) sc = n; else if (n < PC_MLG) sc = n + 16; else if (n < PC_MLG + 16) sc = n - PC_MLG + 6144; else { sc = 0; ok = false; } }
    else if (mat == 1) { K = kD; ld = kD; src = F.in(I_WOUT) + (size_t)l * kD * kD; sc = n; }
    else if (mat == 2) { K = kD; ld = kFF; gk = F.in(I_NPF) + l * kD; const int pn = n >> 8, w = n & 255; src = (w < 128 ? F.in(I_WG) : F.in(I_WU)) + (size_t)l * kD * kFF; sc = pn * 128 + (w & 127); }
    else { K = kFF; ld = kD; src = F.in(I_WD) + (size_t)l * kFF * kD; sc = n; }
#pragma unroll
    for (int i = 0; i < 8; ++i) { const int kk = k8 + 8 * i; float v = ok ? __builtin_nontemporal_load(src + (size_t)(kb * 64 + kk) * ld + sc) : 0.f; if (gk) v *= gk[kb * 64 + kk]; tile[kk * 65 + nn] = v; }
    __syncthreads();
    u16* dst = mat == 0 ? F.WinT(l) : mat == 1 ? F.WoutT(l) : mat == 2 ? F.WguT(l) : F.WdT(l);
    const int rn = F.tid >> 3, kc = F.tid & 7;
    float o[8];
#pragma unroll
    for (int j = 0; j < 8; ++j) o[j] = tile[(8 * kc + j) * 65 + rn];
    *(u32x4*)(dst + (size_t)(nb * 64 + rn) * K + kb * 64 + 8 * kc) = pack8(o);
    __syncthreads();
}
DEV void conv_phase(Frame& F, int l, bool first_only) {
    constexpr int KB2 = kD / 64, KB3 = kFF / 64;
    constexpr int N0 = (kNP / 64) * KB2, N1 = (kD / 64) * KB2, N2 = (2 * kFF / 64) * KB2, N3 = (kD / 64) * KB3;
    for (int it = F.bid; it < N0 + N1 + (first_only ? 0 : N2 + N3); it += F.G) {
        int r = it;
        if (r < N0) { conv_item(F, l, 0, r / KB2, r % KB2); continue; } r -= N0;
        if (r < N1) { conv_item(F, l, 1, r / KB2, r % KB2); continue; } r -= N1;
        if (r < N2) { conv_item(F, l, 2, r / KB2, r % KB2); continue; } r -= N2;
        conv_item(F, l, 3, r / KB3, r % KB3);
    }
}


constexpr int CV_KB2 = kD / 64, CV_KB3 = kFF / 64;
constexpr int CV_N0 = (kNP / 64) * CV_KB2, CV_N1 = (kD / 64) * CV_KB2, CV_N2 = (2 * kFF / 64) * CV_KB2, CV_N3 = (kD / 64) * CV_KB3, CV_NT = CV_N0 + CV_N1 + CV_N2 + CV_N3;
DEV void conv_wave_tile(Frame& F, int l, int it, int lane) {
    int mat, nb, kb; int r = it;
    if (r < CV_N0) { mat = 0; nb = r / CV_KB2; kb = r % CV_KB2; } else { r -= CV_N0;
    if (r < CV_N1) { mat = 1; nb = r / CV_KB2; kb = r % CV_KB2; } else { r -= CV_N1;
    if (r < CV_N2) { mat = 2; nb = r / CV_KB2; kb = r % CV_KB2; } else { r -= CV_N2; mat = 3; nb = r / CV_KB3; kb = r % CV_KB3; } } }
    const int n = nb * 64 + lane;
    const float* src; int ld, sc; bool ok = true; int K; const float* gk = nullptr; u16* dst;
    if (mat == 0) { K = kD; ld = kNIN; src = F.in(I_WIN) + (size_t)l * kD * kNIN; gk = F.in(I_NPM) + l * kD; dst = F.WinT(l);
        if (n < PC_RW) sc = n; else if (n < PC_MLG) sc = n + 16; else if (n < PC_MLG + 16) sc = n - PC_MLG + 6144; else { sc = 0; ok = false; } }
    else if (mat == 1) { K = kD; ld = kD; src = F.in(I_WOUT) + (size_t)l * kD * kD; sc = n; dst = F.WoutT(l); }
    else if (mat == 2) { K = kD; ld = kFF; gk = F.in(I_NPF) + l * kD; const int pn = n >> 8, w = n & 255; src = (w < 128 ? F.in(I_WG) : F.in(I_WU)) + (size_t)l * kD * kFF; sc = pn * 128 + (w & 127); dst = F.WguT(l); }
    else { K = kFF; ld = kD; src = F.in(I_WD) + (size_t)l * kFF * kD; sc = n; dst = F.WdT(l); }
    const float* sp = src + (size_t)(kb * 64) * ld + sc;
#pragma unroll 1
    for (int half = 0; half < 2; ++half) {
        float v[32];
#pragma unroll
        for (int i = 0; i < 32; ++i) v[i] = ok ? __builtin_nontemporal_load(sp + (size_t)(32 * half + i) * ld) : 0.f;
        if (gk) {
#pragma unroll
            for (int i = 0; i < 32; ++i) v[i] *= gk[kb * 64 + 32 * half + i]; }
#pragma unroll
        for (int g = 0; g < 4; ++g) { u32x4 o; o.x = cvtpk(v[8 * g], v[8 * g + 1]); o.y = cvtpk(v[8 * g + 2], v[8 * g + 3]); o.z = cvtpk(v[8 * g + 4], v[8 * g + 5]); o.w = cvtpk(v[8 * g + 6], v[8 * g + 7]);
            *(u32x4*)(dst + (size_t)n * K + kb * 64 + 32 * half + 8 * g) = o; }
    }
}

template <int MODE, bool DUMMY = false> DEV void norm_phase(Frame& F, const float* gy, int wpg = 8) {
    if (F.wave >= wpg) return;
    const int gw = F.bid * wpg + F.wave, NW = F.G * wpg;
    u32x4 yq[4], hq[4];
    if (MODE != 0 && gw < kM) {
#pragma unroll
        for (int j = 0; j < 4; ++j) { yq[j] = __builtin_nontemporal_load((const u32x4*)(F.Y() + (size_t)gw * kD + 8 * (F.lane + 64 * j))); hq[j] = *(const u32x4*)(F.HB() + (size_t)gw * kD + 8 * (F.lane + 64 * j)); }
    }
    for (int m = gw; m < kM; m += NW) {
        float h[32];
        u16* hb = F.HB() + (size_t)m * kD;
        if (MODE == 0) {
            const float* xrow = F.in(I_X) + (size_t)m * kD;
#pragma unroll
            for (int j = 0; j < 4; ++j) { const int e = 8 * (F.lane + 64 * j);
                const f32x4 a = __builtin_nontemporal_load((const f32x4*)(xrow + e)), b = __builtin_nontemporal_load((const f32x4*)(xrow + e + 4));
                h[8 * j + 0] = a.x; h[8 * j + 1] = a.y; h[8 * j + 2] = a.z; h[8 * j + 3] = a.w; h[8 * j + 4] = b.x; h[8 * j + 5] = b.y; h[8 * j + 6] = b.z; h[8 * j + 7] = b.w; }
        } else {
            float y[32]; float ss = 0.f;
#pragma unroll
            for (int j = 0; j < 4; ++j) { unpack8(yq[j], y + 8 * j); unpack8(hq[j], h + 8 * j); }
            if (m + NW < kM) {
#pragma unroll
                for (int j = 0; j < 4; ++j) { yq[j] = __builtin_nontemporal_load((const u32x4*)(F.Y() + (size_t)(m + NW) * kD + 8 * (F.lane + 64 * j))); hq[j] = *(const u32x4*)(F.HB() + (size_t)(m + NW) * kD + 8 * (F.lane + 64 * j)); }
            }
#pragma unroll
            for (int i = 0; i < 32; ++i) ss += y[i] * y[i];
            const float r = 1.0f / sqrtf(sum64(ss) * (1.0f / kD) + kNormEps);
#pragma unroll
            for (int j = 0; j < 4; ++j) { const int e = 8 * (F.lane + 64 * j);
#pragma unroll
                for (int i = 0; i < 8; ++i) h[8 * j + i] += y[8 * j + i] * r * gy[e + i]; }
        }
        if (MODE == 2) {
            float* orow = F.out() + (size_t)m * kD;
#pragma unroll
            for (int j = 0; j < 4; ++j) { const int e = 8 * (F.lane + 64 * j);
                *(f32x4*)(orow + e) = (f32x4){h[8 * j], h[8 * j + 1], h[8 * j + 2], h[8 * j + 3]};
                *(f32x4*)(orow + e + 4) = (f32x4){h[8 * j + 4], h[8 * j + 5], h[8 * j + 6], h[8 * j + 7]}; }
        } else {
            float ss = 0.f;
#pragma unroll
            for (int i = 0; i < 32; ++i) ss += h[i] * h[i];
            const float r2 = 1.0f / sqrtf(sum64(ss) * (1.0f / kD) + kNormEps);
            if (F.lane == 0) F.R2()[m] = r2;
#pragma unroll
            for (int j = 0; j < 4; ++j) *(u32x4*)(hb + 8 * (F.lane + 64 * j)) = pack8(h + 8 * j);
        }
    }
}

constexpr int PL_KX = 0, PL_VX = 16 * 520 * 2, PL_A1 = 2 * 16 * 520 * 2, PL_A2 = PL_A1 + 16 * 72 * 2, PL_A3 = PL_A2 + 16 * 72 * 2, PL_T1 = PL_A3 + 16 * 136 * 2, PL_MU = PL_T1 + 16 * 40 * 2, PL_OT = PL_MU + 1792 * 4, PL_RAW = (PL_OT + 8 * 1536 + 1023) / 1024 * 1024, PL_END = PL_RAW + 65536;
static_assert(PL_RAW % 1024 == 0, "raw tile alignment");
DEV bf16x8 ldsfrag(const LAS u16* base, int stride, int row, int k) { return *(const LAS bf16x8*)(base + row * stride + k); }
DEV bf16x8 glbfrag(const u16* base, int stride, int row, int k) { return *(const bf16x8*)(base + (size_t)row * stride + k); }

DEV void prep_phase(Frame& F, int l) {
    LAS u16* KX = (LAS u16*)(F.lds + PL_KX); LAS u16* VX = (LAS u16*)(F.lds + PL_VX);
    LAS u16* A1 = (LAS u16*)(F.lds + PL_A1); LAS u16* A2 = (LAS u16*)(F.lds + PL_A2); LAS u16* A3 = (LAS u16*)(F.lds + PL_A3); LAS u16* T1 = (LAS u16*)(F.lds + PL_T1);
    LAS float* MU = (LAS float*)(F.lds + PL_MU); LAS float* PT = (LAS float*)(F.lds + PL_OT + F.wave * 1536);
    LAS u16* RAW = (LAS u16*)(F.lds + PL_RAW);
    for (int i = F.tid; i < 1792; i += 512) MU[i] = F.in(I_MU)[(size_t)l * 1792 + i];
    { const int ch = 64 * F.wave + F.lane; PT[F.lane] = F.in(I_W0)[l * 512 + ch]; PT[64 + F.lane] = F.in(I_A0)[l * 512 + ch]; PT[128 + F.lane] = F.in(I_KK)[l * 512 + ch]; PT[192 + F.lane] = F.in(I_KA)[l * 512 + ch];
      PT[256 + F.lane] = l > 0 ? F.in(I_V0)[(l - 1) * 512 + ch] : 0.f; }
    __syncthreads();
    const u16* sw = F.SW() + (size_t)l * SW_LAYER;
    const int w = F.wave, c = F.lane & 15, q = F.lane >> 4;
    bf16x8 wfr[4][2], afr[4][2];
#pragma unroll
    for (int tn = 0; tn < 4; ++tn)
#pragma unroll
        for (int ks = 0; ks < 2; ++ks) { wfr[tn][ks] = glbfrag(sw + SW_WUP, 64, 64 * w + 16 * tn + c, 32 * ks + 8 * q); afr[tn][ks] = glbfrag(sw + SW_AUP, 64, 64 * w + 16 * tn + c, 32 * ks + 8 * q); }
#define PREP_DMA(it_) do { const int tk_ = (it_) * 16; const bool first_ = (tk_ % kS) == 0; _Pragma("unroll") for (int j_ = 0; j_ < 8; ++j_) { int p_ = 512 * w + 64 * j_ + F.lane; if (p_ >= 17 * 224) p_ = 0; \
        const int r_ = p_ / 224, g_ = p_ % 224; const int tok_ = tk_ - 1 + r_ + ((first_ && r_ == 0) ? 1 : 0); \
        glds16(F.P() + (size_t)tok_ * kNP + PC_RW + 8 * g_, RAW + (512 * w + 64 * j_) * 8, F.lane); } } while (0)
    if (F.bid < kM / 16) PREP_DMA(F.bid);
    for (int item = F.bid; item < kM / 16; item += F.G) {
        const int tk0 = item * 16;
        wait_vm0(); __syncthreads();
#define PREP_MIX(row_, col_) float xs[8]; { float cur[8], prv[8]; const u32x4 cq = *(const LAS u32x4*)(RAW + ((row_) + 1) * 1792 + (col_)); u32x4 pq = *(const LAS u32x4*)(RAW + (row_) * 1792 + (col_)); \
            if (((tk0 + (row_)) % kS) == 0) pq = (u32x4){0u, 0u, 0u, 0u}; \
            unpack8(cq, cur); unpack8(pq, prv); const f32x4 m0 = *(const LAS f32x4*)(MU + (col_)), m1 = *(const LAS f32x4*)(MU + (col_) + 4); \
            xs[0] = cur[0] + (prv[0] - cur[0]) * m0.x; xs[1] = cur[1] + (prv[1] - cur[1]) * m0.y; xs[2] = cur[2] + (prv[2] - cur[2]) * m0.z; xs[3] = cur[3] + (prv[3] - cur[3]) * m0.w; \
            xs[4] = cur[4] + (prv[4] - cur[4]) * m1.x; xs[5] = cur[5] + (prv[5] - cur[5]) * m1.y; xs[6] = cur[6] + (prv[6] - cur[6]) * m1.z; xs[7] = cur[7] + (prv[7] - cur[7]) * m1.w; }
#pragma unroll 1
        for (int i = 0; i < 6; ++i) { const int idx = F.tid + 512 * i; const int row = idx / 192, col = 8 * (idx % 192);
            PREP_MIX(row, col);
            if (col < 512) { *(u32x4*)(F.RWS() + (size_t)(tk0 + row) * kRWS + RS_R + col) = pack8(xs); }
            else if (col < 1024) { *(LAS u32x4*)(KX + row * 520 + (col - 512)) = pack8(xs); }
            else { *(LAS u32x4*)(VX + row * 520 + (col - 1024)) = pack8(xs); } }
        int lt_ = F.tid;
#ifndef HOST_EMU
        asm volatile("" : "+v"(lt_));
#endif
        if (w < 2) { const int p = lt_, row = p >> 3, cg = 8 * (p & 7);
            PREP_MIX(row, 1536 + cg);
#pragma unroll
            for (int e = 0; e < 8; ++e) { const float t = fexp(2.0f * xs[e]); xs[e] = 1.0f - 2.0f * frcp(t + 1.0f); }
            *(LAS u32x4*)(A1 + row * 72 + cg) = pack8(xs); }
        else if (w < 4) { const int p = lt_ - 128, row = p >> 3, cg = 8 * (p & 7);
            PREP_MIX(row, 1600 + cg);
            *(LAS u32x4*)(A2 + row * 72 + cg) = pack8(xs); }
        else { const int p = lt_ - 256, row = p >> 4, cg = 8 * (p & 15);
            PREP_MIX(row, 1664 + cg);
#pragma unroll
            for (int e = 0; e < 8; ++e) xs[e] = fsig(xs[e]);
            *(LAS u32x4*)(A3 + row * 136 + cg) = pack8(xs); }
#undef PREP_MIX
        __syncthreads();
        if (item + F.G < kM / 16) PREP_DMA(item + F.G);
        bf16x8 gfr[4][4];
#pragma unroll
        for (int tn = 0; tn < 4; ++tn) {
#pragma unroll
            for (int ks = 0; ks < 4; ++ks) gfr[tn][ks] = glbfrag(sw + SW_GUP, 128, 64 * w + 16 * tn + c, 32 * ks + 8 * q); }
        if (l > 0) {
            if (w < 2) { const int tn = w; f32x4 acc = {0.f, 0.f, 0.f, 0.f}; bf16x8 dn[16];
#pragma unroll
                for (int ks = 0; ks < 16; ++ks) dn[ks] = glbfrag(sw + SW_VDN, 512, 16 * tn + c, 32 * ks + 8 * q);
#pragma unroll
                for (int ks = 0; ks < 16; ++ks) acc = mfma16(ldsfrag(VX, 520, c, 32 * ks + 8 * q), dn[ks], acc);
#pragma unroll
                for (int j = 0; j < 4; ++j) T1[(4 * q + j) * 40 + 16 * tn + c] = f2bf(acc[j]); }
            __syncthreads();
        }
        {
            const int trow = c;
            int pto = 4 * q;
#ifndef HOST_EMU
            asm volatile("" : "+v"(pto));
#endif
            const LAS float* PTq = PT + pto;
            u16* orow = F.RWS() + (size_t)(tk0 + trow) * kRWS + 64 * w + 4 * q;
#pragma unroll
            for (int tn = 0; tn < 4; ++tn) { f32x4 acc = {0.f, 0.f, 0.f, 0.f};
#pragma unroll
                for (int ks = 0; ks < 4; ++ks) acc = mfma16(gfr[tn][ks], ldsfrag(A3, 136, trow, 32 * ks + 8 * q), acc);
                u32x2 o; o.x = cvtpk(acc[0], acc[1]); o.y = cvtpk(acc[2], acc[3]);
                *(u32x2*)(orow + RS_G + 16 * tn) = o; }
            bf16x8 vfr[4]; u32x2 vfq[4];
#pragma unroll
            for (int tn = 0; tn < 4; ++tn) vfr[tn] = glbfrag(sw + SW_VUP, 32, 64 * w + 16 * tn + c, 8 * q);
            if (l > 0) {
#pragma unroll
                for (int tn = 0; tn < 4; ++tn) vfq[tn] = *(const u32x2*)(F.VF() + (size_t)(tk0 + trow) * kG + 64 * w + 16 * tn + 4 * q); }
            const bf16x8 x10 = ldsfrag(A1, 72, trow, 8 * q), x11 = ldsfrag(A1, 72, trow, 32 + 8 * q), x20 = ldsfrag(A2, 72, trow, 8 * q), x21 = ldsfrag(A2, 72, trow, 32 + 8 * q);
#pragma unroll
            for (int tn = 0; tn < 4; ++tn) { f32x4 acc = {0.f, 0.f, 0.f, 0.f};
                acc = mfma16(wfr[tn][0], x10, acc); acc = mfma16(wfr[tn][1], x11, acc);
                const f32x4 w0v = *(const LAS f32x4*)(PTq + 16 * tn);
                u32x2 o; o.x = cvtpk(fexp(-kDecayScale * fsig(w0v.x + acc[0])), fexp(-kDecayScale * fsig(w0v.y + acc[1]))); o.y = cvtpk(fexp(-kDecayScale * fsig(w0v.z + acc[2])), fexp(-kDecayScale * fsig(w0v.w + acc[3])));
                *(u32x2*)(orow + RS_W + 16 * tn) = o; }
            f32x4 av[4]; float ss = 0.f;
#pragma unroll
            for (int tn = 0; tn < 4; ++tn) { f32x4 acc = {0.f, 0.f, 0.f, 0.f};
                acc = mfma16(afr[tn][0], x20, acc); acc = mfma16(afr[tn][1], x21, acc);
                const f32x4 a0v = *(const LAS f32x4*)(PTq + 64 + 16 * tn), kkv = *(const LAS f32x4*)(PTq + 128 + 16 * tn);
                const u32x2 kb = *(const LAS u32x2*)(KX + trow * 520 + 64 * w + 16 * tn + 4 * q);
                const f32x4 kf = {bf2f((u16)(kb.x & 0xffffu)), bf2f((u16)(kb.x >> 16)), bf2f((u16)(kb.y & 0xffffu)), bf2f((u16)(kb.y >> 16))};
                av[tn] = (f32x4){fsig(a0v.x + acc[0]), fsig(a0v.y + acc[1]), fsig(a0v.z + acc[2]), fsig(a0v.w + acc[3])};
                const f32x4 kr = kf * kkv; ss += (kr.x * kr.x + kr.y * kr.y) + (kr.z * kr.z + kr.w * kr.w); }
            ss += lxany(ss, F.lane, 16); ss += lxany(ss, F.lane, 32);
            const float inv = 1.0f / fmaxf(sqrtf(ss), 1e-12f);
#pragma unroll
            for (int tn = 0; tn < 4; ++tn) {
                const f32x4 kkv = *(const LAS f32x4*)(PTq + 128 + 16 * tn), kav = *(const LAS f32x4*)(PTq + 192 + 16 * tn);
                const u32x2 kb = *(const LAS u32x2*)(KX + trow * 520 + 64 * w + 16 * tn + 4 * q);
                const f32x4 kf = {bf2f((u16)(kb.x & 0xffffu)), bf2f((u16)(kb.x >> 16)), bf2f((u16)(kb.y & 0xffffu)), bf2f((u16)(kb.y >> 16))};
                const f32x4 a = av[tn], kkn = kf * kkv * inv, kp = kf * (1.0f + (a - 1.0f) * kav), bb = a * kkn;
                u32x2 o; o.x = cvtpk(kp.x, kp.y); o.y = cvtpk(kp.z, kp.w); *(u32x2*)(orow + RS_K + 16 * tn) = o;
                o.x = cvtpk(kkn.x, kkn.y); o.y = cvtpk(kkn.z, kkn.w); *(u32x2*)(orow + RS_KK + 16 * tn) = o;
                o.x = cvtpk(bb.x, bb.y); o.y = cvtpk(bb.z, bb.w); *(u32x2*)(orow + RS_B + 16 * tn) = o; }
            const bf16x8 t1f = ldsfrag(T1, 40, trow, 8 * q);
#pragma unroll
            for (int tn = 0; tn < 4; ++tn) {
                f32x4 acc = {0.f, 0.f, 0.f, 0.f};
                if (l > 0) acc = mfma16(vfr[tn], t1f, acc);
                const u32x2 vb = *(const LAS u32x2*)(VX + trow * 520 + 64 * w + 16 * tn + 4 * q);
                f32x4 vo = {bf2f((u16)(vb.x & 0xffffu)), bf2f((u16)(vb.x >> 16)), bf2f((u16)(vb.y & 0xffffu)), bf2f((u16)(vb.y >> 16))};
                if (l > 0) { const f32x4 v0v = *(const LAS f32x4*)(PTq + 256 + 16 * tn);
                    const f32x4 v1 = {bf2f((u16)(vfq[tn].x & 0xffffu)), bf2f((u16)(vfq[tn].x >> 16)), bf2f((u16)(vfq[tn].y & 0xffffu)), bf2f((u16)(vfq[tn].y >> 16))};
                    const f32x4 mix = {fsig(v0v.x + acc[0]), fsig(v0v.y + acc[1]), fsig(v0v.z + acc[2]), fsig(v0v.w + acc[3])};
                    vo = vo + (v1 - vo) * mix; }
                else *(u32x2*)(F.VF() + (size_t)(tk0 + trow) * kG + 64 * w + 16 * tn + 4 * q) = vb;
                u32x2 o; o.x = cvtpk(vo.x, vo.y); o.y = cvtpk(vo.z, vo.w); *(u32x2*)(orow + RS_V + 16 * tn) = o; }
        }
    }
#undef PREP_DMA
}

#ifndef RWKV_SCAN_MFMA
#define RWKV_SCAN_MFMA 1
#endif
constexpr int SL_TB = 32, SL_TS = SL_TB * 64;
constexpr int SL_BUF = 7 * SL_TS * 4;
constexpr int SL_Y = 2 * SL_BUF, SL_U = SL_Y + 2 * SL_TS * 4, SL_END = SL_U + 2 * (SL_TB / 2) * 256 * 2;
DEV float dot4(f32x4 a, f32x4 b) { return (a.x * b.x + a.y * b.y) + (a.z * b.z + a.w * b.w); }
DEV void rwkv_scan(Frame& F, int l, int b, int hh) {
    constexpr int TB = SL_TB, TS = SL_TS, NB = kS / TB;
    int tid_ = F.tid;
#ifndef HOST_EMU
    asm volatile("" : "+v"(tid_));
#endif
    const int xtid = tid_, xlane = tid_ & 63;
    const int mq = xlane >> 4, mi0 = 16 * (F.wave & 3) + (xlane & 15);
    f32x4 SA0 = {0.f, 0.f, 0.f, 0.f}, SA1 = SA0, SB0 = SA0, SB1 = SA0; bf16x8 sA = {0, 0, 0, 0, 0, 0, 0, 0}, sB = sA;
    const int es = xtid & 15, ech = 64 * hh + 4 * es;
    const f32x4 lnw = *(const f32x4*)(F.in(I_LNW) + l * 512 + ech), lnb = *(const f32x4*)(F.in(I_LNB) + l * 512 + ech), rk = *(const f32x4*)(F.in(I_RK) + l * 512 + ech);
    const u16* rws = F.RWS() + (size_t)b * kS * kRWS + 64 * hh;
    const int hid = xtid - 256, hp = (hid >> 3) & 15, hg = hid & 7;
    u32x4 pre[14];
    const unsigned hoffb = (unsigned)((2 * hp) * kRWS + 8 * hg) * 2u;
#define RW_LOAD(blk_) do { const char* rb_ = (const char*)(rws + (size_t)(blk_) * TB * kRWS); _Pragma("unroll") for (int rr_ = 0; rr_ < 2; ++rr_) _Pragma("unroll") for (int tz_ = 0; tz_ < 7; ++tz_) \
        pre[7 * rr_ + tz_] = __builtin_nontemporal_load((const u32x4*)(rb_ + hoffb + (unsigned)((rr_ * kRWS + tz_ * 512) * 2))); } while (0)
#define PUT8(slot_, row_, v_) do { LAS float* d_ = LTn + (slot_) * TS + (row_) * 64 + 8 * hg; *(LAS f32x4*)d_ = (f32x4){(v_)[0], (v_)[1], (v_)[2], (v_)[3]}; *(LAS f32x4*)(d_ + 4) = (f32x4){(v_)[4], (v_)[5], (v_)[6], (v_)[7]}; } while (0)
#define PUTU(row_, v_) do { u32x4 o_; o_.x = cvtpk((v_)[0], (v_)[1]); o_.y = cvtpk((v_)[2], (v_)[3]); o_.z = cvtpk((v_)[4], (v_)[5]); o_.w = cvtpk((v_)[6], (v_)[7]); *(LAS u32x4*)(Un + hp * 256 + (row_) * 64 + 8 * hg) = o_; } while (0)
#define DOT8(a_, b_) ((((a_)[0] * (b_)[0] + (a_)[1] * (b_)[1]) + ((a_)[2] * (b_)[2] + (a_)[3] * (b_)[3])) + (((a_)[4] * (b_)[4] + (a_)[5] * (b_)[5]) + ((a_)[6] * (b_)[6] + (a_)[7] * (b_)[7])))
#define RW_STAGE(bi_) do { LAS float* LTn = (LAS float*)(F.lds + (bi_) * SL_BUF); LAS u16* Un = (LAS u16*)(F.lds + SL_U + (bi_) * (TB / 2) * 512); \
        float r1[8], w1[8], k1[8], x1[8], kk1[8], b1[8], r2[8], w2[8], k2[8], kk2[8], b2[8], t_[8], u_[8]; \
        unpack8(pre[0], r1); unpack8(pre[1], w1); unpack8(pre[2], k1); unpack8(pre[4], kk1); unpack8(pre[5], b1); \
        unpack8(pre[7], r2); unpack8(pre[8], w2); unpack8(pre[9], k2); unpack8(pre[11], kk2); unpack8(pre[12], b2); \
        PUT8(0, 2 * hp, r1); PUT8(0, 2 * hp + 1, r2); PUT8(2, 2 * hp, k1); PUT8(2, 2 * hp + 1, k2); PUT8(5, 2 * hp + 1, b2); \
        unpack8(pre[3], x1); PUT8(3, 2 * hp, x1); unpack8(pre[10], x1); PUT8(3, 2 * hp + 1, x1); unpack8(pre[6], x1); PUT8(6, 2 * hp, x1); unpack8(pre[13], x1); PUT8(6, 2 * hp + 1, x1); \
        PUTU(0, kk1); \
        const float c0 = sum8(DOT8(k1, kk2)), c1 = sum8(DOT8(b1, kk2)), c2 = sum8(DOT8(k1, r1)), c3 = sum8(DOT8(b1, r1)), c6 = sum8(DOT8(k2, r2)), c7 = sum8(DOT8(b2, r2)); \
        _Pragma("unroll") for (int e_ = 0; e_ < 8; ++e_) t_[e_] = w1[e_] * kk2[e_]; PUTU(1, t_); \
        _Pragma("unroll") for (int e_ = 0; e_ < 8; ++e_) t_[e_] = w1[e_] * r1[e_]; PUTU(2, t_); \
        _Pragma("unroll") for (int e_ = 0; e_ < 8; ++e_) u_[e_] = w1[e_] * w2[e_]; PUT8(1, 2 * hp, u_); \
        _Pragma("unroll") for (int e_ = 0; e_ < 8; ++e_) t_[e_] = u_[e_] * r2[e_]; PUTU(3, t_); \
        _Pragma("unroll") for (int e_ = 0; e_ < 8; ++e_) t_[e_] = k1[e_] * w2[e_]; PUT8(1, 2 * hp + 1, t_); const float c4 = sum8(DOT8(t_, r2)); \
        _Pragma("unroll") for (int e_ = 0; e_ < 8; ++e_) t_[e_] = b1[e_] * w2[e_]; PUT8(5, 2 * hp, t_); const float c5 = sum8(DOT8(t_, r2)); \
        if (hg == 0) { LAS float* d_ = LTn + 4 * TS + (2 * hp) * 64; *(LAS f32x4*)d_ = (f32x4){c0, c1, c2, c3}; *(LAS f32x4*)(d_ + 4) = (f32x4){c4, c5, c6, c7}; } } while (0)
    const bool helper = F.wave == 4 || F.wave == 5;
    if (helper) { RW_LOAD(0); RW_STAGE(0); if (NB > 1) RW_LOAD(1); }
    lds_sync();
    for (int blk = 0; blk < NB; ++blk) {
        const int bi = blk & 1; const size_t tok0 = (size_t)b * kS + (size_t)blk * TB;
        LAS float* LT = (LAS float*)(F.lds + bi * SL_BUF); LAS float* LY = (LAS float*)(F.lds + SL_Y + bi * TS * 4); LAS u16* LU = (LAS u16*)(F.lds + SL_U + bi * (TB / 2) * 512);
        if (F.wave < 4) {
#pragma unroll 2
        for (int pi = 0; pi < TB / 2; ++pi) {
            const f32x4 z4 = {0.f, 0.f, 0.f, 0.f};
            const LAS u16* uf = LU + pi * 256 + (xlane & 3) * 64 + 8 * mq;
            f32x4 acc = mfma16(*(const LAS bf16x8*)uf, sA, z4);
            acc = mfma16(*(const LAS bf16x8*)(uf + 32), sB, acc);
            const LAS float* base = LT + (2 * pi) * 64 + 8 * mq;
            const f32x4 wa0 = *(const LAS f32x4*)(base + TS), wa1 = *(const LAS f32x4*)(base + TS + 4), wb0 = *(const LAS f32x4*)(base + TS + 32), wb1 = *(const LAS f32x4*)(base + TS + 36);
            const f32x4 ka0 = *(const LAS f32x4*)(base + TS + 64), ka1 = *(const LAS f32x4*)(base + TS + 68), kb0 = *(const LAS f32x4*)(base + TS + 96), kb1 = *(const LAS f32x4*)(base + TS + 100);
            const f32x4 ba0 = *(const LAS f32x4*)(base + 5 * TS), ba1 = *(const LAS f32x4*)(base + 5 * TS + 4), bb0 = *(const LAS f32x4*)(base + 5 * TS + 32), bb1 = *(const LAS f32x4*)(base + 5 * TS + 36);
            const f32x4 kc0 = *(const LAS f32x4*)(base + 2 * TS + 64), kc1 = *(const LAS f32x4*)(base + 2 * TS + 68), kd0 = *(const LAS f32x4*)(base + 2 * TS + 96), kd1 = *(const LAS f32x4*)(base + 2 * TS + 100);
            const f32x4 bc0 = *(const LAS f32x4*)(base + 5 * TS + 64), bc1 = *(const LAS f32x4*)(base + 5 * TS + 68), bd0 = *(const LAS f32x4*)(base + 5 * TS + 96), bd1 = *(const LAS f32x4*)(base + 5 * TS + 100);
            const f32x4 s0 = *(const LAS f32x4*)(LT + 4 * TS + (2 * pi) * 64), s1 = *(const LAS f32x4*)(LT + 4 * TS + (2 * pi) * 64 + 4);
            const float v1 = LT[3 * TS + (2 * pi) * 64 + mi0], v2 = LT[3 * TS + (2 * pi + 1) * 64 + mi0];
            const float p1 = acc[0];
            const float p2 = (acc[1] + v1 * s0[0]) - p1 * s0[1];
            const float y1 = (acc[2] + v1 * s0[2]) - p1 * s0[3];
            const float y2 = ((acc[3] + v1 * s1[0]) - p1 * s1[1]) + (v2 * s1[2] - p2 * s1[3]);
            SA0 = ((SA0 * wa0 + ka0 * v1) - ba0 * p1) + (kc0 * v2 - bc0 * p2); SA1 = ((SA1 * wa1 + ka1 * v1) - ba1 * p1) + (kc1 * v2 - bc1 * p2);
            SB0 = ((SB0 * wb0 + kb0 * v1) - bb0 * p1) + (kd0 * v2 - bd0 * p2); SB1 = ((SB1 * wb1 + kb1 * v1) - bb1 * p1) + (kd1 * v2 - bd1 * p2);
            { u32x4 pk; pk.x = cvtpk(SA0.x, SA0.y); pk.y = cvtpk(SA0.z, SA0.w); pk.z = cvtpk(SA1.x, SA1.y); pk.w = cvtpk(SA1.z, SA1.w); sA = __builtin_bit_cast(bf16x8, pk); }
            { u32x4 pk; pk.x = cvtpk(SB0.x, SB0.y); pk.y = cvtpk(SB0.z, SB0.w); pk.z = cvtpk(SB1.x, SB1.y); pk.w = cvtpk(SB1.z, SB1.w); sB = __builtin_bit_cast(bf16x8, pk); }
            if (mq == 0) { LY[(2 * pi) * 64 + mi0] = y1; LY[(2 * pi + 1) * 64 + mi0] = y2; }
        }
        } else if (helper && blk + 1 < NB) { RW_STAGE(bi ^ 1); if (blk + 2 < NB) RW_LOAD(blk + 2); }
        lds_sync();
        {
            const int et = xtid >> 4;
            const f32x4 y = *(const LAS f32x4*)(LY + et * 64 + 4 * es);
            const f32x4 r = *(const LAS f32x4*)(LT + et * 64 + 4 * es), k = *(const LAS f32x4*)(LT + 2 * TS + et * 64 + 4 * es), v = *(const LAS f32x4*)(LT + 3 * TS + et * 64 + 4 * es);
            const f32x4 g = *(const LAS f32x4*)(LT + 6 * TS + et * 64 + 4 * es);
            const float mean = sum16(y.x + y.y + y.z + y.w) * (1.0f / 64.0f);
            const f32x4 d = y - mean;
            const float var = sum16(d.x * d.x + d.y * d.y + d.z * d.z + d.w * d.w) * (1.0f / 64.0f);
            const float rstd = frsq(var + kRwkvLnEps);
            const float bonus = sum16(r.x * k.x * rk.x + r.y * k.y * rk.y + r.z * k.z * rk.z + r.w * k.w * rk.w);
            u32x2 o;
            o.x = cvtpk((d.x * rstd * lnw.x + lnb.x + bonus * v.x) * g.x, (d.y * rstd * lnw.y + lnb.y + bonus * v.y) * g.y);
            o.y = cvtpk((d.z * rstd * lnw.z + lnb.z + bonus * v.z) * g.z, (d.w * rstd * lnw.w + lnb.w + bonus * v.w) * g.w);
            *(u32x2*)(F.O() + (tok0 + et) * kD + 1536 + ech) = o;
        }
        lds_sync();
    }
#undef RW_LOAD
#undef RW_STAGE
#undef PUT8
#undef PUTU
#undef DOT8
}

constexpr int CQ = 72, CT = 40;
constexpr int CL_QP = 0, CL_KP = 32 * CQ, CL_KT = 2 * 32 * CQ, CL_VT = CL_KT + 64 * CT, CL_PM = CL_VT + 80 * CT, CL_ST = CL_PM + 32 * CT, CL_E16 = CL_ST + 80 * CQ;
constexpr int CL_DEC = CL_E16 * 2;
constexpr int CL_RAW = CL_DEC + 256;
constexpr int CL_BYTES = CL_RAW + 16384;
static_assert(CL_RAW % 1024 == 0 || true, "raw");

template <int KIND> DEV void chain_abc(Frame& F, LAS unsigned char* wl, int l, int b, int hh) {
    constexpr int NTE = KIND == 2 ? 5 : 4;
    constexpr int NCH = kS / 32;
    LAS u16* QP = (LAS u16*)wl + CL_QP; LAS u16* KP = (LAS u16*)wl + CL_KP; LAS u16* KT = (LAS u16*)wl + CL_KT; LAS u16* VT = (LAS u16*)wl + CL_VT;
    LAS u16* PM = (LAS u16*)wl + CL_PM; LAS u16* ST = (LAS u16*)wl + CL_ST; LAS float* DEC = (LAS float*)(wl + CL_DEC); LAS u16* RAW = (LAS u16*)(wl + CL_RAW);
    int lane_ = F.lane;
#ifndef HOST_EMU
    asm volatile("" : "+v"(lane_));
#endif
    const int lane = lane_, d = lane, c = lane & 15, q = lane >> 4;
    const int pbase = KIND == 0 ? PC_RET : KIND == 1 ? PC_HG : PC_ML;
    const int obase = 512 * KIND + 64 * hh;
    const u16* pchain = F.P() + (size_t)b * kS * kNP + pbase + 64 * hh;
    float gam = 1.f, igam = 1.f, g32 = 1.f, cdl = 1.f, sdl = 0.f, tc_n = 1.f, ts_n = 0.f;
    float lb = 0.f;
    float cwq[4] = {0, 0, 0, 0}, cwk[4] = {0, 0, 0, 0}, cbq = 0.f, cbk = 0.f, ibias = 0.f, fbias = 0.f;
    float qh1 = 0.f, qh2 = 0.f, qh3 = 0.f, kh1 = 0.f, kh2 = 0.f, kh3 = 0.f;
    float nw[4] = {1.f, 1.f, 1.f, 1.f};
    float gi_n = 0.f, gf_n = 0.f;
    if (KIND == 0) { const float lg = log1pf(-exp2f(-5.0f - (float)hh)); gam = expf(lg); igam = expf(-lg); g32 = expf(32.0f * lg);
        const float* tr = F.TRIG() + 2 * (d & 31); tc_n = tr[0]; ts_n = tr[1]; cdl = tr[64]; sdl = tr[65]; }
    if (KIND == 1) {
        const float* lg4 = F.in(I_HLB) + 64 * hh + d; float e[4], mx = -1e30f, sm = 0.f;
#pragma unroll
        for (int i = 0; i < 4; ++i) { e[i] = lg4[i * 512]; mx = fmaxf(mx, e[i]); }
#pragma unroll
        for (int i = 0; i < 4; ++i) { e[i] = expf(e[i] - mx); sm += e[i]; }
#pragma unroll
        for (int i = 1; i < 4; ++i) if (i <= l) lb += e[i] / sm;
#pragma unroll
        for (int tn = 0; tn < 4; ++tn) nw[tn] = F.in(I_HNW)[l * 512 + 64 * hh + 16 * tn + c];
    }
    if (KIND == 2) {
        const float* cw = F.in(I_MCW) + (size_t)l * 4 * 1024;
#pragma unroll
        for (int j = 0; j < 4; ++j) { cwq[j] = cw[j * 1024 + 64 * hh + d]; cwk[j] = cw[j * 1024 + 512 + 64 * hh + d]; }
        cbq = F.in(I_MCB)[l * 1024 + 64 * hh + d]; cbk = F.in(I_MCB)[l * 1024 + 512 + 64 * hh + d];
        ibias = F.in(I_MIB)[l * 8 + hh]; fbias = F.in(I_MFB)[l * 8 + hh];
#pragma unroll
        for (int tn = 0; tn < 4; ++tn) nw[tn] = F.in(I_MNW)[l * 512 + 64 * hh + 16 * tn + c];
        for (int i = lane; i < 16 * CT; i += 64) VT[64 * CT + i] = (i < CT) ? (u16)0x3F80 : (u16)0;
    }
    for (int i = lane; i < 80 * CQ; i += 64) ST[i] = 0;
    f32x4 accS[4][NTE];
#pragma unroll
    for (int dm = 0; dm < 4; ++dm)
#pragma unroll
        for (int te = 0; te < NTE; ++te) accS[dm][te] = (f32x4){0.f, 0.f, 0.f, 0.f};
    const unsigned dma_off = (unsigned)((lane >> 3) * kNP + 8 * (lane & 7));
    const unsigned gate_off = (unsigned)(lane * kNP + hh);
    const unsigned st_off = (unsigned)((lane >> 3) * kD + 8 * (lane & 7));
    const u16* pgate = F.P() + (size_t)b * kS * kNP + PC_MLG;
    u16* uchain = F.O() + (size_t)b * kS * kD + obase;
#define CH_DMA(ch_) do { const u16* g_ = pchain + (size_t)(ch_) * 32 * kNP; \
        _Pragma("unroll") for (int T_ = 0; T_ < 4; ++T_) _Pragma("unroll") for (int rb_ = 0; rb_ < 4; ++rb_) glds16(g_ + (512 * T_ + 8 * rb_ * kNP) + dma_off, RAW + T_ * 2048 + rb_ * 512, lane); } while (0)
#define CH_DMA_RB(ch_, rb_) do { const u16* g_ = pchain + (size_t)(ch_) * 32 * kNP; \
        _Pragma("unroll") for (int T_ = 0; T_ < 4; ++T_) glds16(g_ + (512 * T_ + 8 * (rb_) * kNP) + dma_off, RAW + T_ * 2048 + (rb_) * 512, lane); } while (0)
#define CH_NEXT_RB(r_) do { if ((((r_) + 2) & 7) == 0 && ch + 1 < NCH) { asm volatile("s_waitcnt lgkmcnt(0)" ::: "memory"); CH_DMA_RB(ch + 1, (r_) >> 3); } } while (0)
    CH_DMA(0);
    if (KIND == 2 && lane < 32) { const u16* grow = pgate + gate_off; gi_n = bf2f(grow[0]); gf_n = bf2f(grow[8]); }
    wave_sync();

#pragma unroll 1
    for (int ch = 0; ch < NCH; ++ch) {
        const int t0 = ch * 32; const size_t tok0 = (size_t)b * kS + t0;
        float adec = 1.f;
        wait_vm0(); wave_sync();
        unsigned gpk[2][4][2];
#pragma unroll
        for (int tm = 0; tm < 2; ++tm)
#pragma unroll
            for (int j = 0; j < 4; ++j) { const LAS u16* gr = RAW + 3 * 2048 + (16 * tm + 4 * q + j) * 64 + c;
                gpk[tm][j][0] = (unsigned)gr[0] | ((unsigned)gr[16] << 16); gpk[tm][j][1] = (unsigned)gr[32] | ((unsigned)gr[48] << 16); }
        const float gi_c = gi_n, gf_c = gf_n;
        const int swz = (d >> 3) & 3;
#define KTV_IDX(r_) (d * CT + 8 * (((r_) >> 3) ^ swz) + ((r_) & 7))
        if (KIND == 0) {
            float qd = gam, kd = igam;
            float cs = tc_n, sn = ts_n;
#pragma unroll 2
            for (int r = 0; r < 32; r += 2) {
                float qx[2], kx[2]; u16 vb[2];
#pragma unroll
                for (int u = 0; u < 2; ++u) {
                    const float qv = bf2f(RAW[(r + u) * 64 + d]), kv = bf2f(RAW[2048 + (r + u) * 64 + d]); vb[u] = RAW[4096 + (r + u) * 64 + d];
                    const float qo = xswap32(qv, d < 32), ko = xswap32(kv, d < 32);
                    const float qr = d < 32 ? qv * cs - qo * sn : qo * sn + qv * cs;
                    const float kr = (d < 32 ? kv * cs - ko * sn : ko * sn + kv * cs) * 0.125f;
                    qx[u] = qr * qd; kx[u] = kr * kd; qd *= gam; kd *= igam;
                    { const float c2 = cs * cdl - sn * sdl; sn = sn * cdl + cs * sdl; cs = c2; }
                }
                const unsigned qp = cvtpk(qx[0], qx[1]), kp = cvtpk(kx[0], kx[1]);
                QP[r * CQ + d] = (u16)(qp & 0xffffu); QP[(r + 1) * CQ + d] = (u16)(qp >> 16); KP[r * CQ + d] = (u16)(kp & 0xffffu); KP[(r + 1) * CQ + d] = (u16)(kp >> 16);
                *(LAS unsigned*)(KT + KTV_IDX(r)) = kp; *(LAS unsigned*)(VT + KTV_IDX(r)) = (unsigned)vb[0] | ((unsigned)vb[1] << 16);
                CH_NEXT_RB(r);
            }
            adec = g32;
        } else if (KIND == 1) {
            float E = 1.f;
#pragma unroll 2
            for (int r = 0; r < 32; r += 2) {
                float qx[2], kx[2]; u16 vb[2];
#pragma unroll
                for (int u = 0; u < 2; ++u) {
                    const float qv = bf2f(RAW[(r + u) * 64 + d]), fv = bf2f(RAW[2048 + (r + u) * 64 + d]); vb[u] = RAW[4096 + (r + u) * 64 + d];
                    const float ft = lb + (1.0f - lb) * fsig(fv);
                    E = fmaxf(E * ft, 1e-30f);
                    qx[u] = qv * fsig(qv) * 0.125f * E; kx[u] = (1.0f - ft) * frcp(E);
                }
                const unsigned qp = cvtpk(qx[0], qx[1]), kp = cvtpk(kx[0], kx[1]);
                QP[r * CQ + d] = (u16)(qp & 0xffffu); QP[(r + 1) * CQ + d] = (u16)(qp >> 16); KP[r * CQ + d] = (u16)(kp & 0xffffu); KP[(r + 1) * CQ + d] = (u16)(kp >> 16);
                *(LAS unsigned*)(KT + KTV_IDX(r)) = kp; *(LAS unsigned*)(VT + KTV_IDX(r)) = (unsigned)vb[0] | ((unsigned)vb[1] << 16);
                CH_NEXT_RB(r);
            }
            DEC[d] = E;
        } else {
            const float li = gi_c + ibias, lf = logsig(gf_c + fbias);
            const float Fc = scan32(lf);
            const float eF = fexp(Fc), eK = fexp(li - Fc);
            adec = rdlane(eF, 31);
#pragma unroll
            for (int r = 0; r < 32; r += 2) {
                float qx[2], kx[2]; u16 vb[2];
#pragma unroll
                for (int u = 0; u < 2; ++u) {
                    const float eFr = rdlane(eF, r + u), eKr = rdlane(eK, r + u);
                    const float qv = bf2f(RAW[(r + u) * 64 + d]), kv = bf2f(RAW[2048 + (r + u) * 64 + d]); vb[u] = RAW[4096 + (r + u) * 64 + d];
                    float qc = cbq + cwq[0] * qh3 + cwq[1] * qh2 + cwq[2] * qh1 + cwq[3] * qv;
                    float kc = cbk + cwk[0] * kh3 + cwk[1] * kh2 + cwk[2] * kh1 + cwk[3] * kv;
                    qh3 = qh2; qh2 = qh1; qh1 = qv; kh3 = kh2; kh2 = kh1; kh1 = kv;
                    qx[u] = qc * fsig(qc) * eFr; kx[u] = kc * fsig(kc) * 0.125f * eKr;
                }
                const unsigned qp = cvtpk(qx[0], qx[1]), kp = cvtpk(kx[0], kx[1]);
                QP[r * CQ + d] = (u16)(qp & 0xffffu); QP[(r + 1) * CQ + d] = (u16)(qp >> 16); KP[r * CQ + d] = (u16)(kp & 0xffffu); KP[(r + 1) * CQ + d] = (u16)(kp >> 16);
                *(LAS unsigned*)(KT + KTV_IDX(r)) = kp; *(LAS unsigned*)(VT + KTV_IDX(r)) = (unsigned)vb[0] | ((unsigned)vb[1] << 16);
                CH_NEXT_RB(r);
            }
        }
#undef KTV_IDX
        wave_sync();
        if (ch + 1 < NCH) {
            if (KIND == 2 && lane < 32) { unsigned go_ = gate_off;
#ifndef HOST_EMU
                asm volatile("" : "+v"(go_));
#endif
                const u16* grow = pgate + (size_t)(t0 + 32) * kNP + go_; gi_n = bf2f(grow[0]); gf_n = bf2f(grow[8]); }
            if (KIND == 0) { const float* tr = F.TRIG() + 2 * ((t0 + 32) * 32 + (d & 31)); tc_n = tr[0]; ts_n = tr[1]; }
        }
        bf16x8 qa[2][2];
        {
            bf16x8 kb[2][2];
#pragma unroll
            for (int x = 0; x < 2; ++x)
#pragma unroll
                for (int ks = 0; ks < 2; ++ks) { qa[x][ks] = ldsfrag(QP, CQ, 16 * x + c, 32 * ks + 8 * q); kb[x][ks] = ldsfrag(KP, CQ, 16 * x + c, 32 * ks + 8 * q); }
#pragma unroll
            for (int tm = 0; tm < 2; ++tm)
#pragma unroll
                for (int sn = 0; sn < 2; ++sn) {
                    f32x4 acc = {0.f, 0.f, 0.f, 0.f};
                    if (sn <= tm) {
#pragma unroll
                        for (int ks = 0; ks < 2; ++ks) acc = mfma16(kb[sn][ks], qa[tm][ks], acc);
                    }
                    const int t = 16 * tm + c, sb = 16 * sn + 4 * q;
                    u32x2 pk; pk.x = cvtpk(sb <= t ? acc[0] : 0.f, sb + 1 <= t ? acc[1] : 0.f); pk.y = cvtpk(sb + 2 <= t ? acc[2] : 0.f, sb + 3 <= t ? acc[3] : 0.f);
                    *(LAS u32x2*)(PM + t * CT + sb) = pk;
                }
        }
        wave_sync();
        {
#pragma unroll
            for (int tm = 0; tm < 2; ++tm) {
                const bf16x8 pa = ldsfrag(PM, CT, 16 * tm + c, 8 * q);
                f32x4 out[NTE];
#pragma unroll
                for (int te = 0; te < NTE; ++te) {
                    const int row = 16 * te + c;
                    const bf16x8 vt = ldsfrag(VT, CT, row, 8 * (q ^ ((row >> 3) & 3))), st0 = ldsfrag(ST, CQ, row, 8 * q), st1 = ldsfrag(ST, CQ, row, 32 + 8 * q);
                    f32x4 acc = {0.f, 0.f, 0.f, 0.f};
                    acc = mfma16(pa, vt, acc); acc = mfma16(qa[tm][0], st0, acc); acc = mfma16(qa[tm][1], st1, acc);
                    out[te] = acc;
                }
#pragma unroll
                for (int j = 0; j < 4; ++j) {
                    float v[4];
#pragma unroll
                    for (int te = 0; te < 4; ++te) v[te] = out[te][j];
                    if (KIND == 2) { const float den = sum16(out[NTE - 1][j]);     const float sc = frcp(fmaxf(fabsf(den), 1.0f));
#pragma unroll
                        for (int te = 0; te < 4; ++te) v[te] *= sc; }
                    const float ss = sum16(v[0] * v[0] + v[1] * v[1] + v[2] * v[2] + v[3] * v[3]);
                    const float rs = frsq(ss * (1.0f / 64.0f) + kNormEps);
#pragma unroll
                    for (int te = 0; te < 4; ++te) { const unsigned gw = gpk[tm][j][te >> 1]; const float g = bf2f((u16)((te & 1) ? (gw >> 16) : (gw & 0xffffu)));
                        const float gate = KIND == 0 ? g * fsig(g) : fsig(g);
                        KP[(16 * tm + 4 * q + j) * CQ + 16 * te + c] = (u16)(cvtpk(v[te] * rs * nw[te] * gate, 0.f) & 0xffffu); }
                }
            }
        }
        wave_sync();
#pragma unroll
        for (int i = 0; i < 4; ++i) { const int row = 8 * i + (lane >> 3), cg = lane & 7;
            *(u32x4*)(uchain + (size_t)(t0 + 8 * i) * kD + st_off) = *(const LAS u32x4*)(KP + row * CQ + 8 * cg); }
        {
            bf16x8 vt[NTE], kt[4];
#pragma unroll
            for (int te = 0; te < NTE; ++te) { const int row = 16 * te + c; vt[te] = ldsfrag(VT, CT, row, 8 * (q ^ ((row >> 3) & 3))); }
#pragma unroll
            for (int dm = 0; dm < 4; ++dm) { const int row = 16 * dm + c; kt[dm] = ldsfrag(KT, CT, row, 8 * (q ^ ((row >> 3) & 3))); }
#pragma unroll
            for (int dm = 0; dm < 4; ++dm) {
                f32x4 av;
                if (KIND == 1) av = *(const LAS f32x4*)(DEC + 16 * dm + 4 * q); else av = (f32x4){adec, adec, adec, adec};
#pragma unroll
                for (int te = 0; te < NTE; ++te) {
                    f32x4 acc = mfma16(kt[dm], vt[te], accS[dm][te]);
                    acc = acc * av; accS[dm][te] = acc;
                    u32x2 pk; pk.x = cvtpk(acc[0], acc[1]); pk.y = cvtpk(acc[2], acc[3]);
                    *(LAS u32x2*)(ST + (16 * te + c) * CQ + 16 * dm + 4 * q) = pk;
                }
            }
        }
        wave_sync();
    }
#undef CH_DMA
#undef CH_DMA_RB
#undef CH_NEXT_RB
}

constexpr int RL_RAW = 0;
constexpr int RL_AL = RL_RAW + 7 * 2048, RL_BE = RL_AL + 2304, RL_KA = RL_BE + 2304, RL_RH = RL_KA + 2304, RL_RK = RL_RH + 2304;
constexpr int RL_BET = RL_RK + 2304, RL_KAT = RL_BET + 2048, RL_VT = RL_KAT + 2048, RL_UT = RL_VT + 2048, RL_ZT = RL_UT + 2048;
constexpr int RL_BM = RL_ZT + 2048, RL_CM = RL_BM + 512, RL_DM = RL_CM + 512, RL_TI = RL_DM + 512, RL_AF = RL_TI + 512;
constexpr int RL_SI = RL_AF + 1024, RL_DEC = RL_SI + 64 * 72 * 2, RL_ZERO = RL_DEC + 256, RL_OT = RL_ZERO + 64, RL_END = RL_OT + 2048;
static_assert(RL_END <= CL_BYTES, "rwkv chain lds");
DEV bf16x8 fragT(const LAS u16* base, const LAS u16* zero, int row, int q) { return *(const LAS bf16x8*)(q < 2 ? base + row * 16 + 8 * q : zero); }

DEV void chain_rwkv(Frame& F, LAS unsigned char* wl, int l, int b, int hh) {
    constexpr int NCH = kS / 16;
    LAS u16* RAW = (LAS u16*)(wl + RL_RAW); LAS u16* AL = (LAS u16*)(wl + RL_AL); LAS u16* BE = (LAS u16*)(wl + RL_BE); LAS u16* KA = (LAS u16*)(wl + RL_KA); LAS u16* RH = (LAS u16*)(wl + RL_RH); LAS u16* RK = (LAS u16*)(wl + RL_RK);
    LAS u16* BET = (LAS u16*)(wl + RL_BET); LAS u16* KAT = (LAS u16*)(wl + RL_KAT); LAS u16* VT = (LAS u16*)(wl + RL_VT); LAS u16* UT = (LAS u16*)(wl + RL_UT); LAS u16* ZT = (LAS u16*)(wl + RL_ZT);
    LAS u16* BM = (LAS u16*)(wl + RL_BM); LAS u16* CM = (LAS u16*)(wl + RL_CM); LAS u16* DM = (LAS u16*)(wl + RL_DM); LAS u16* TI = (LAS u16*)(wl + RL_TI); LAS float* AF = (LAS float*)(wl + RL_AF);
    LAS u16* SI = (LAS u16*)(wl + RL_SI); LAS float* DEC = (LAS float*)(wl + RL_DEC); LAS u16* ZERO = (LAS u16*)(wl + RL_ZERO); LAS u16* OT = (LAS u16*)(wl + RL_OT);
    int lane_ = F.lane;
#ifndef HOST_EMU
    asm volatile("" : "+v"(lane_));
#endif
    const int lane = lane_, d = lane, c = lane & 15, q = lane >> 4;
    const float rkd = F.in(I_RK)[l * 512 + 64 * hh + d];
    float lnw[4], lnb[4];
#pragma unroll
    for (int tv = 0; tv < 4; ++tv) { lnw[tv] = F.in(I_LNW)[l * 512 + 64 * hh + 16 * tv + c]; lnb[tv] = F.in(I_LNB)[l * 512 + 64 * hh + 16 * tv + c]; }
    for (int i = lane; i < 64 * 72; i += 64) SI[i] = 0;
    if (lane < 32) ZERO[lane] = 0;
    f32x4 accH[4][4];
#pragma unroll
    for (int tk = 0; tk < 4; ++tk)
#pragma unroll
        for (int tv = 0; tv < 4; ++tv) accH[tk][tv] = (f32x4){0.f, 0.f, 0.f, 0.f};
    const u16* rws = F.RWS() + (size_t)b * kS * kRWS + 64 * hh;
    u16* ochain = F.O() + (size_t)b * kS * kD + 1536 + 64 * hh;
    const unsigned dma_off = (unsigned)((lane >> 3) * kRWS + 8 * (lane & 7));
    const unsigned st_off = (unsigned)((lane >> 3) * kD + 8 * (lane & 7));
#define RW_DMA(ch_) do { const u16* g_ = rws + (size_t)(ch_) * 16 * kRWS; \
        _Pragma("unroll") for (int T_ = 0; T_ < 7; ++T_) _Pragma("unroll") for (int rb_ = 0; rb_ < 2; ++rb_) glds16(g_ + (512 * T_ + 8 * rb_ * kRWS) + dma_off, RAW + T_ * 1024 + rb_ * 512, lane); } while (0)
    RW_DMA(0);
    wave_sync();
#pragma unroll 1
    for (int ch = 0; ch < NCH; ++ch) {
        const int t0 = ch * 16;
        wait_vm0(); wave_sync();
        float Wc = 1.f;
#pragma unroll 4
        for (int j = 0; j < 16; j += 2) {
            float al[2], be[2], ka[2], rh[2], rk2[2]; u16 vb[2];
#pragma unroll
            for (int u = 0; u < 2; ++u) {
                const int o = (j + u) * 64 + d;
                const float rv = bf2f(RAW[o]), wv = bf2f(RAW[1024 + o]), kv = bf2f(RAW[2048 + o]), kkv = bf2f(RAW[4096 + o]), bv = bf2f(RAW[5120 + o]); vb[u] = RAW[3072 + o];
                al[u] = kkv * Wc; Wc *= wv; const float iw = frcp(Wc);
                be[u] = bv * iw; ka[u] = kv * iw; rh[u] = rv * Wc; rk2[u] = rv * rkd;
            }
            const unsigned pa = cvtpk(al[0], al[1]), pb = cvtpk(be[0], be[1]), pk = cvtpk(ka[0], ka[1]), pr = cvtpk(rh[0], rh[1]), pq = cvtpk(rk2[0], rk2[1]), pn = cvtpk(-be[0], -be[1]);
            AL[j * 72 + d] = (u16)(pa & 0xffffu); AL[(j + 1) * 72 + d] = (u16)(pa >> 16); BE[j * 72 + d] = (u16)(pb & 0xffffu); BE[(j + 1) * 72 + d] = (u16)(pb >> 16);
            KA[j * 72 + d] = (u16)(pk & 0xffffu); KA[(j + 1) * 72 + d] = (u16)(pk >> 16); RH[j * 72 + d] = (u16)(pr & 0xffffu); RH[(j + 1) * 72 + d] = (u16)(pr >> 16);
            RK[j * 72 + d] = (u16)(pq & 0xffffu); RK[(j + 1) * 72 + d] = (u16)(pq >> 16);
            *(LAS unsigned*)(BET + d * 16 + j) = pn; *(LAS unsigned*)(KAT + d * 16 + j) = pk; *(LAS unsigned*)(VT + d * 16 + j) = (unsigned)vb[0] | ((unsigned)vb[1] << 16);
        }
        DEC[d] = Wc;
        wave_sync();
        {
            bf16x8 fa[2], fb[2], fk[2], fr[2];
#pragma unroll
            for (int ks = 0; ks < 2; ++ks) { fa[ks] = ldsfrag(AL, 72, c, 32 * ks + 8 * q); fb[ks] = ldsfrag(BE, 72, c, 32 * ks + 8 * q); fk[ks] = ldsfrag(KA, 72, c, 32 * ks + 8 * q); fr[ks] = ldsfrag(RH, 72, c, 32 * ks + 8 * q); }
            f32x4 mA = {0.f, 0.f, 0.f, 0.f}, mB = mA, mC = mA, mD = mA;
#pragma unroll
            for (int ks = 0; ks < 2; ++ks) { mA = mfma16(fb[ks], fa[ks], mA); mB = mfma16(fk[ks], fa[ks], mB); mC = mfma16(fb[ks], fr[ks], mC); mD = mfma16(fk[ks], fr[ks], mD); }
            const int sb = 4 * q;
            *(LAS f32x4*)(AF + c * 16 + sb) = (f32x4){sb < c ? mA[0] : 0.f, sb + 1 < c ? mA[1] : 0.f, sb + 2 < c ? mA[2] : 0.f, sb + 3 < c ? mA[3] : 0.f};
            u32x2 w2;
            w2.x = cvtpk(sb < c ? mB[0] : 0.f, sb + 1 < c ? mB[1] : 0.f); w2.y = cvtpk(sb + 2 < c ? mB[2] : 0.f, sb + 3 < c ? mB[3] : 0.f); *(LAS u32x2*)(BM + c * 16 + sb) = w2;
            w2.x = cvtpk(sb <= c ? -mC[0] : 0.f, sb + 1 <= c ? -mC[1] : 0.f); w2.y = cvtpk(sb + 2 <= c ? -mC[2] : 0.f, sb + 3 <= c ? -mC[3] : 0.f); *(LAS u32x2*)(CM + c * 16 + sb) = w2;
            w2.x = cvtpk(sb <= c ? mD[0] : 0.f, sb + 1 <= c ? mD[1] : 0.f); w2.y = cvtpk(sb + 2 <= c ? mD[2] : 0.f, sb + 3 <= c ? mD[3] : 0.f); *(LAS u32x2*)(DM + c * 16 + sb) = w2;
        }
        float bonus[4];
        {
            f32x4 mb = {0.f, 0.f, 0.f, 0.f};
#pragma unroll
            for (int ks = 0; ks < 2; ++ks) mb = mfma16(ldsfrag(RK, 72, c, 32 * ks + 8 * q), ldsfrag(RAW + 2048, 64, c, 32 * ks + 8 * q), mb);
#pragma unroll
            for (int i = 0; i < 4; ++i) bonus[i] = sum16(c == 4 * q + i ? mb[i] : 0.f);
        }
        unsigned vg[4][4];
#pragma unroll
        for (int i = 0; i < 4; ++i)
#pragma unroll
            for (int tv = 0; tv < 4; ++tv) { const int o = (4 * q + i) * 64 + 16 * tv + c; vg[i][tv] = (unsigned)RAW[3072 + o] | ((unsigned)RAW[6144 + o] << 16); }
        wave_sync();
        if (ch + 1 < NCH) RW_DMA(ch + 1);
        {
            float t[16];
            const int scol = lane & 15;
            f32x4 af[16][4];
#pragma unroll
            for (int j = 1; j < 16; ++j)
#pragma unroll
                for (int m4 = 0; m4 < (j + 3) / 4; ++m4) af[j][m4] = *(const LAS f32x4*)(AF + j * 16 + 4 * m4);
#pragma unroll
            for (int j = 0; j < 16; ++j) {
                float acc0 = (j == scol) ? 1.f : 0.f, acc1 = 0.f;
#pragma unroll
                for (int m = 0; m < j; ++m) { if (m & 1) acc1 -= af[j][m >> 2][m & 3] * t[m]; else acc0 -= af[j][m >> 2][m & 3] * t[m]; }
                t[j] = acc0 + acc1;
            }
            if (lane < 16) {
#pragma unroll
                for (int j = 0; j < 16; ++j) TI[j * 16 + scol] = (u16)(cvtpk(t[j], 0.f) & 0xffffu); }
        }
        wave_sync();
        {
            const bf16x8 a0 = ldsfrag(AL, 72, c, 8 * q), a1 = ldsfrag(AL, 72, c, 32 + 8 * q), bm = fragT(BM, ZERO, c, q);
#pragma unroll
            for (int tv = 0; tv < 4; ++tv) { const int row = 16 * tv + c;
                f32x4 z = {0.f, 0.f, 0.f, 0.f};
                z = mfma16(a0, ldsfrag(SI, 72, row, 8 * q), z); z = mfma16(a1, ldsfrag(SI, 72, row, 32 + 8 * q), z); z = mfma16(bm, fragT(VT, ZERO, row, q), z);
                u32x2 w2; w2.x = cvtpk(z[0], z[1]); w2.y = cvtpk(z[2], z[3]); *(LAS u32x2*)(ZT + row * 16 + 4 * q) = w2; }
        }
        wave_sync();
        {
            const bf16x8 ti = fragT(TI, ZERO, c, q);
#pragma unroll
            for (int tv = 0; tv < 4; ++tv) { const int row = 16 * tv + c;
                f32x4 u = {0.f, 0.f, 0.f, 0.f};
                u = mfma16(ti, fragT(ZT, ZERO, row, q), u);
                u32x2 w2; w2.x = cvtpk(u[0], u[1]); w2.y = cvtpk(u[2], u[3]); *(LAS u32x2*)(UT + row * 16 + 4 * q) = w2; }
        }
        wave_sync();
        {
            const bf16x8 r0 = ldsfrag(RH, 72, c, 8 * q), r1 = ldsfrag(RH, 72, c, 32 + 8 * q), cm = fragT(CM, ZERO, c, q), dm = fragT(DM, ZERO, c, q);
            f32x4 y[4];
#pragma unroll
            for (int tv = 0; tv < 4; ++tv) { const int row = 16 * tv + c;
                f32x4 a = {0.f, 0.f, 0.f, 0.f};
                a = mfma16(r0, ldsfrag(SI, 72, row, 8 * q), a); a = mfma16(r1, ldsfrag(SI, 72, row, 32 + 8 * q), a);
                a = mfma16(cm, fragT(UT, ZERO, row, q), a); a = mfma16(dm, fragT(VT, ZERO, row, q), a);
                y[tv] = a; }
#pragma unroll
            for (int i = 0; i < 4; ++i) {
                const float mean = sum16((y[0][i] + y[1][i]) + (y[2][i] + y[3][i])) * (1.0f / 64.0f);
                const float d0 = y[0][i] - mean, d1 = y[1][i] - mean, d2 = y[2][i] - mean, d3 = y[3][i] - mean;
                const float var = sum16((d0 * d0 + d1 * d1) + (d2 * d2 + d3 * d3)) * (1.0f / 64.0f);
                const float rstd = frsq(var + kRwkvLnEps);
                const float dd[4] = {d0, d1, d2, d3};
#pragma unroll
                for (int tv = 0; tv < 4; ++tv) { const float vv = bf2f((u16)(vg[i][tv] & 0xffffu)), gg = bf2f((u16)(vg[i][tv] >> 16));
                    OT[(4 * q + i) * 64 + 16 * tv + c] = (u16)(cvtpk((dd[tv] * rstd * lnw[tv] + lnb[tv] + bonus[i] * vv) * gg, 0.f) & 0xffffu); }
            }
        }
        wave_sync();
#pragma unroll
        for (int i = 0; i < 2; ++i) { const int row = 8 * i + (lane >> 3), cg = lane & 7;
            *(u32x4*)(ochain + (size_t)(t0 + 8 * i) * kD + st_off) = *(const LAS u32x4*)(OT + row * 64 + 8 * cg); }
        {
            bf16x8 ut[4], vt[4];
#pragma unroll
            for (int tv = 0; tv < 4; ++tv) { ut[tv] = fragT(UT, ZERO, 16 * tv + c, q); vt[tv] = fragT(VT, ZERO, 16 * tv + c, q); }
#pragma unroll
            for (int tk = 0; tk < 4; ++tk) {
                const bf16x8 nb = fragT(BET, ZERO, 16 * tk + c, q), kt = fragT(KAT, ZERO, 16 * tk + c, q);
                const f32x4 dv = *(const LAS f32x4*)(DEC + 16 * tk + 4 * q);
#pragma unroll
                for (int tv = 0; tv < 4; ++tv) {
                    f32x4 h = mfma16(nb, ut[tv], accH[tk][tv]); h = mfma16(kt, vt[tv], h);
                    h = h * dv; accH[tk][tv] = h;
                    u32x2 w2; w2.x = cvtpk(h[0], h[1]); w2.y = cvtpk(h[2], h[3]);
                    *(LAS u32x2*)(SI + (16 * tv + c) * 72 + 16 * tk + 4 * q) = w2;
                }
            }
        }
        wave_sync();
    }
#undef RW_DMA
}

#ifndef KMASK
#define KMASK 15
#endif
#ifndef RWKV_CHUNKED
#define RWKV_CHUNKED 0
#endif
DEV void mix_phase(Frame& F, int l) {
#if RWKV_CHUNKED
    constexpr int NCHAIN = 4 * kB * kH, NITEM = (NCHAIN + 2) / 3;
    for (int item = F.bid; item < NITEM; item += F.G) {
        const int cid = item * 3 + F.wave;
#ifndef HOST_EMU
        if (F.wave >= 3) {
            if (l == 0) for (int it = CV_N0 + CV_N1 + item * 5 + (F.wave - 3); it < CV_NT; it += NITEM * 5) conv_wave_tile(F, 0, it, F.lane);
            if (l + 1 < kL) for (int it = item * 5 + (F.wave - 3); it < CV_NT; it += NITEM * 5) conv_wave_tile(F, l + 1, it, F.lane);
        }
#endif
        if (F.wave < 3 && cid < NCHAIN) {
            const int kind = cid % 4, r = cid / 4;
            LAS unsigned char* wl = F.lds + F.wave * CL_BYTES;
            if ((KMASK & 1) && kind == 0) chain_abc<0>(F, wl, l, r / kH, r % kH);
            else if ((KMASK & 2) && kind == 1) chain_abc<1>(F, wl, l, r / kH, r % kH);
            else if ((KMASK & 4) && kind == 2) chain_abc<2>(F, wl, l, r / kH, r % kH);
            else if ((KMASK & 8) && kind == 3) chain_rwkv(F, wl, l, r / kH, r % kH);
        }
        __syncthreads();
    }
#else
    constexpr int NRW = kB * kH, NABC = 3 * kB * kH, NITEM = NRW + (NABC + 2) / 3;
    for (int item = F.bid; item < NITEM; item += F.G) {
        if (item < NRW) { if (KMASK & 8) rwkv_scan(F, l, item / kH, item % kH); }
        else {
            const int cid = (item - NRW) * 3 + F.wave;
#ifndef HOST_EMU
            if (F.wave >= 3) {
                if (l == 0) for (int it = CV_N0 + CV_N1 + (item - NRW) * 5 + (F.wave - 3); it < CV_NT; it += (NITEM - NRW) * 5) conv_wave_tile(F, 0, it, F.lane);
                if (l + 1 < kL) for (int it = (item - NRW) * 5 + (F.wave - 3); it < CV_NT; it += (NITEM - NRW) * 5) conv_wave_tile(F, l + 1, it, F.lane);
            }
#endif
            if (F.wave < 3 && cid < NABC) {
                const int kind = cid / (kB * kH), r = cid % (kB * kH);
                LAS unsigned char* wl = F.lds + F.wave * CL_BYTES;
#ifndef HOST_EMU
                __builtin_amdgcn_s_setprio(3);
#endif
                if ((KMASK & 1) && kind == 0) chain_abc<0>(F, wl, l, r / kH, r % kH);
                else if ((KMASK & 2) && kind == 1) chain_abc<1>(F, wl, l, r / kH, r % kH);
                else if ((KMASK & 4) && kind == 2) chain_abc<2>(F, wl, l, r / kH, r % kH);
#ifndef HOST_EMU
                __builtin_amdgcn_s_setprio(0);
#endif
            }
            __syncthreads();
        }
    }
#endif
}

template <int MODE> DEV void simple_gemm_phase(Frame& F, const u16* A, const u16* Bt, int M, int N, int K, u16* O, int ldo) {
    LAS u16* As = (LAS u16*)F.lds;
    LAS u16* Bs = (LAS u16*)F.lds + 128 * 40;
    const int c = F.lane & 15, q = F.lane >> 4, w = F.wave;
    const int NT = MODE == 0 ? N / 64 : N / 128, MT = M / 128;
    for (int tile = F.bid; tile < MT * NT; tile += F.G) {
        const int tm = tile / NT, tn = tile % NT;
        f32x4 acc[2][4];
#pragma unroll
        for (int h = 0; h < 2; ++h)
#pragma unroll
            for (int j = 0; j < 4; ++j) acc[h][j] = (f32x4){0.f, 0.f, 0.f, 0.f};
        for (int k0 = 0; k0 < K; k0 += 32) {
            { const int r = F.tid >> 2, g = F.tid & 3; *(LAS u32x4*)(As + r * 40 + 8 * g) = *(const u32x4*)(A + (size_t)(tm * 128 + r) * K + k0 + 8 * g); }
            if (MODE == 0) { if (F.tid < 256) { const int r = F.tid >> 2, g = F.tid & 3; *(LAS u32x4*)(Bs + r * 40 + 8 * g) = *(const u32x4*)(Bt + (size_t)(tn * 64 + r) * K + k0 + 8 * g); } }
            else { const int r = F.tid >> 2, g = F.tid & 3; const int un = tn >> 1, off = (tn & 1) * 64; const int brow = un * 256 + (r < 64 ? off + r : 128 + off + (r - 64));
                *(LAS u32x4*)(Bs + r * 40 + 8 * g) = *(const u32x4*)(Bt + (size_t)brow * K + k0 + 8 * g); }
            __syncthreads();
            const bf16x8 af = ldsfrag(As, 40, 16 * w + c, 8 * q);
#pragma unroll
            for (int h = 0; h < (MODE == 0 ? 1 : 2); ++h)
#pragma unroll
                for (int j = 0; j < 4; ++j) acc[h][j] = mfma16(af, ldsfrag(Bs, 40, 64 * h + 16 * j + c, 8 * q), acc[h][j]);
            __syncthreads();
        }
#pragma unroll
        for (int j = 0; j < 4; ++j)
#pragma unroll
            for (int i = 0; i < 4; ++i) { const size_t row = (size_t)tm * 128 + 16 * w + 4 * q + i; const int col = tn * 64 + 16 * j + c;
                if (MODE == 0) O[row * ldo + col] = f2bf(acc[0][j][i]);
                else { const float g = acc[0][j][i], up = acc[1][j][i]; O[row * ldo + col] = f2bf(g / (1.0f + expf(-g)) * up); } }
    }
}

#ifndef HOST_EMU
__device__ __forceinline__ unsigned xb_ld(unsigned* p);
__device__ __forceinline__ unsigned xb_add(unsigned* p, unsigned v);
namespace pg8 {
#define PG8_LAS __attribute__((address_space(3)))
typedef unsigned short bf16_t;
constexpr int BM = 256, BK = 64, HALF = 128, HTB = HALF * BK * 2, STAGE_BYTES = 8 * HTB, NXCD = 8, WGM = 8;
__host__ __device__ __forceinline__ int lds_byte(int r, int c) { const int st = (r >> 4) * 2 + (c >> 5), rr = r & 15, cc = c & 31, ob = rr * 64 + cc * 2; return st * 1024 + (ob ^ (((ob >> 9) & 1) << 5)); }
__host__ __device__ __forceinline__ void stage_rc(int b, int& R, int& C) { const int st = b / 1024, sb = b % 1024, swz = sb ^ (((sb >> 9) & 1) << 5); R = (st >> 1) * 16 + swz / 64; C = (st & 1) * 32 + (swz % 64) / 2; }
__host__ __device__ __forceinline__ int perm32(int rho) { const int n = rho >> 4, i = rho & 15; return 8 * (i >> 2) + 4 * n + (i & 3); }
struct Unit { int pm, pn; };
struct Gemm { const bf16_t* A; const bf16_t* Bt; int M, N, K; };
struct StaticOrder {
    int nM, nN, nwg, G, c;
    __host__ __device__ void init(int M, int N, int G_, int c_) { nM = M / BM; nN = N / BM; nwg = nM * nN; G = G_; c = c_; }
    __host__ __device__ bool next(int i, Unit& u) const {
        const long L = (long)i * G + c; if (L >= nwg) return false;
        int wgid = (int)L; { const int q = nwg / NXCD, r = nwg % NXCD, xcd = wgid % NXCD, off = wgid / NXCD; wgid = (xcd < r ? xcd * (q + 1) : r * (q + 1) + (xcd - r) * q) + off; }
        const int nig = WGM * nN, gid = wgid / nig, fm = gid * WGM, gsz = (nM - fm) < WGM ? (nM - fm) : WGM;
        u.pm = fm + ((wgid % nig) % gsz); u.pn = (wgid % nig) / gsz; return true;
    }
    __device__ __forceinline__ void a_ready(const Unit&) const {}
    __device__ __forceinline__ void done(const Unit&) const {}
};
__device__ __forceinline__ unsigned cvt_pk_bf16(float lo, float hi) { unsigned r; asm volatile("v_cvt_pk_bf16_f32 %0, %1, %2" : "=v"(r) : "v"(lo), "v"(hi)); return r; }
template <bool SCALE> struct EpiBf16 {
    static constexpr bool PERM = true, AFTER_DRAIN = false, HAS_SCALE = SCALE;
    bf16_t* O; int ldc; const float* rs; PG8_LAS float* scl;
    __device__ __forceinline__ void prefetch(const Unit& u, int par, int wid, int lane) const {
        if (SCALE && wid < 4) __builtin_amdgcn_global_load_lds((const unsigned*)(rs + u.pm * BM + 64 * wid + lane), (PG8_LAS unsigned*)(scl + par * 256 + 64 * wid), 4, 0, 0); }
    __device__ __forceinline__ void operator()(const f32x4 (&acc)[2][2][4][2], const Unit& u, int wr, int wc, int fr, int fq, int par) const {
        const int row0 = u.pm * BM + wr * 64 + fr; const int col0 = u.pn * BM + wc * 32 + 8 * fq;
#pragma unroll
        for (int ai = 0; ai < 2; ++ai)
#pragma unroll
            for (int m = 0; m < 4; ++m) { bf16_t* rowp = O + (size_t)(row0 + ai * HALF + m * 16) * ldc + col0; const float sc = SCALE ? scl[par * 256 + wr * 64 + fr + ai * HALF + m * 16] : 1.0f;
#pragma unroll
                for (int bj = 0; bj < 2; ++bj) { const f32x4 v0 = acc[ai][bj][m][0] * sc, v1 = acc[ai][bj][m][1] * sc;
                    u32x4 w; w.x = cvt_pk_bf16(v0[0], v0[1]); w.y = cvt_pk_bf16(v0[2], v0[3]); w.z = cvt_pk_bf16(v1[0], v1[1]); w.w = cvt_pk_bf16(v1[2], v1[3]);
                    if (SCALE) __builtin_nontemporal_store(w, (u32x4*)(rowp + bj * HALF)); else *(u32x4*)(rowp + bj * HALF) = w; } }
    }
};
struct EpiSwiGlu {
    static constexpr bool PERM = true, AFTER_DRAIN = false, HAS_SCALE = true;
    bf16_t* O; int ldc; const float* rs; PG8_LAS float* scl;
    __device__ __forceinline__ void prefetch(const Unit& u, int par, int wid, int lane) const {
        if (wid < 4) __builtin_amdgcn_global_load_lds((const unsigned*)(rs + u.pm * BM + 64 * wid + lane), (PG8_LAS unsigned*)(scl + par * 256 + 64 * wid), 4, 0, 0); }
    __device__ __forceinline__ void operator()(const f32x4 (&acc)[2][2][4][2], const Unit& u, int wr, int wc, int fr, int fq, int par) const {
        const int row0 = u.pm * BM + wr * 64 + fr; const int col0 = u.pn * HALF + wc * 32 + 8 * fq;
#pragma unroll
        for (int ai = 0; ai < 2; ++ai)
#pragma unroll
            for (int m = 0; m < 4; ++m) { bf16_t* rowp = O + (size_t)(row0 + ai * HALF + m * 16) * ldc + col0; const float sc = scl[par * 256 + wr * 64 + fr + ai * HALF + m * 16];
                float o[8];
#pragma unroll
                for (int n = 0; n < 2; ++n)
#pragma unroll
                    for (int j = 0; j < 4; ++j) { const float g = acc[ai][0][m][n][j] * sc, up = acc[ai][1][m][n][j] * sc; o[4 * n + j] = g * __builtin_amdgcn_rcpf(1.0f + __expf(-g)) * up; }
                u32x4 w; w.x = cvt_pk_bf16(o[0], o[1]); w.y = cvt_pk_bf16(o[2], o[3]); w.z = cvt_pk_bf16(o[4], o[5]); w.w = cvt_pk_bf16(o[6], o[7]);
                __builtin_nontemporal_store(w, (u32x4*)rowp); }
    }
};

struct PanelOrder {
    int nM, ngrp, g, pn;
    __device__ void init(int M, int G_, int c_) { nM = M / BM; ngrp = G_ / 8;
        if (G_ % 64 == 0) { const int x = c_ & 7, j = c_ >> 3; g = x + 8 * (j >> 3); pn = j & 7; } else { g = c_ >> 3; pn = c_ & 7; }
        if (c_ >= 8 * ngrp) g = 1 << 28; }
    __device__ bool next(int i, Unit& u) const { const long pm = (long)i * ngrp + g; if (pm >= nM) return false; u.pm = (int)pm; u.pn = pn; return true; }
    __device__ __forceinline__ void a_ready(const Unit&) const {}
    __device__ __forceinline__ void done(const Unit&) const {}
};
#define PG8_EPI_BAR() do { asm volatile("s_waitcnt vmcnt(0) lgkmcnt(0)" ::: "memory"); __builtin_amdgcn_s_barrier(); } while (0)
template <bool FINAL> struct EpiResNorm {
    static constexpr bool PERM = true, AFTER_DRAIN = false, HAS_SCALE = false;
    float* OUT; bf16_t* H; const float* gy; float* XP; float* XQ; float* R2; unsigned* cnt; unsigned* tmo; PG8_LAS float* red;
    __device__ __forceinline__ void prefetch(const Unit&, int, int, int) const {}
    __device__ __forceinline__ float rowsum(int row) const { float t = 0.f;
#pragma unroll
        for (int s_ = 0; s_ < 16; ++s_) t += red[s_ * 256 + row];
        return t; }
    static __device__ __forceinline__ void xst(float* p, float v) { __hip_atomic_store(p, v, __ATOMIC_RELAXED, __HIP_MEMORY_SCOPE_AGENT); }
    static __device__ __forceinline__ float xld(const float* p) { return __hip_atomic_load(p, __ATOMIC_RELAXED, __HIP_MEMORY_SCOPE_AGENT); }
    static __device__ __forceinline__ float sum8x(const float* p) { float v[8];
#pragma unroll
        for (int i = 0; i < 8; ++i) v[i] = xld(p + i);
        return ((v[0] + v[1]) + (v[2] + v[3])) + ((v[4] + v[5]) + (v[6] + v[7])); }
    __device__ __forceinline__ void operator()(const f32x4 (&acc)[2][2][4][2], const Unit& u, int wr, int wc, int fr_, int fq_, int) const {
        int fr = fr_, fq = fq_; asm volatile("" : "+v"(fr), "+v"(fq));
        const int tid = (wr * 4 + wc) * 64 + fq * 16 + fr, slot = (wc * 4 + fq) * 256;
        PG8_LAS float* tab = red + 16 * 256; volatile PG8_LAS unsigned* flag = (volatile PG8_LAS unsigned*)(red + 17 * 256);
        const size_t prow = (size_t)u.pm * BM;
        const int col0 = u.pn * BM + wc * 32 + 8 * fq;
        u32x4 hq[2][4][2];
#pragma unroll
        for (int ai = 0; ai < 2; ++ai)
#pragma unroll
            for (int m = 0; m < 4; ++m) { const bf16_t* rp = H + (prow + ai * HALF + wr * 64 + m * 16 + fr) * 2048 + col0; hq[ai][m][0] = *(const u32x4*)rp; hq[ai][m][1] = *(const u32x4*)(rp + HALF); }
#pragma unroll
        for (int ai = 0; ai < 2; ++ai)
#pragma unroll
            for (int m = 0; m < 4; ++m) { float s_ = 0.f;
#pragma unroll
                for (int bj = 0; bj < 2; ++bj)
#pragma unroll
                    for (int n = 0; n < 2; ++n) { const f32x4 v = acc[ai][bj][m][n]; s_ += (v[0] * v[0] + v[1] * v[1]) + (v[2] * v[2] + v[3] * v[3]); }
                red[slot + ai * HALF + wr * 64 + m * 16 + fr] = s_; }
        asm volatile("s_waitcnt lgkmcnt(0)" ::: "memory"); __builtin_amdgcn_s_barrier();
        if (tid < 256) { xst(XP + (prow + tid) * 8 + u.pn, rowsum(tid)); asm volatile("s_waitcnt vmcnt(0)" ::: "memory"); }
        __builtin_amdgcn_s_barrier();
        if (tid == 0) { unsigned* c_ = cnt + u.pm; asm volatile("" : "+s"(c_));
            (void)xb_add(c_, 1u);
            { unsigned sp_ = 0; while (xb_ld(c_) < 8u) { __builtin_amdgcn_s_sleep(1); if ((++sp_ & 255u) == 0u) { if (xb_ld(tmo)) break; if (sp_ > (1u << 27)) { atomicAdd(tmo, 1u); break; } } } } }
        f32x4 gv[2][2];
#pragma unroll
        for (int bj = 0; bj < 2; ++bj) { gv[bj][0] = *(const f32x4*)(gy + col0 + bj * HALF); gv[bj][1] = *(const f32x4*)(gy + col0 + bj * HALF + 4); }
        asm volatile("s_waitcnt lgkmcnt(0)" ::: "memory"); __builtin_amdgcn_s_barrier();
        if (tid < 256) tab[tid] = 1.0f / sqrtf(sum8x(XP + (prow + tid) * 8) * (1.0f / 2048.0f) + 1e-6f);
        asm volatile("s_waitcnt lgkmcnt(0)" ::: "memory"); __builtin_amdgcn_s_barrier();
#pragma unroll
        for (int ai = 0; ai < 2; ++ai)
#pragma unroll
            for (int m = 0; m < 4; ++m) { const int rl = ai * HALF + wr * 64 + m * 16 + fr; const float rs = tab[rl]; bf16_t* rowp = H + (prow + rl) * 2048 + col0; float hs = 0.f;
#pragma unroll
                for (int bj = 0; bj < 2; ++bj) { const u32x4 hv = hq[ai][m][bj];
                    const f32x4 y0 = acc[ai][bj][m][0] * rs * gv[bj][0], y1 = acc[ai][bj][m][1] * rs * gv[bj][1];
                    float o[8];
                    o[0] = __builtin_bit_cast(float, hv.x << 16) + y0[0]; o[1] = __builtin_bit_cast(float, hv.x & 0xffff0000u) + y0[1]; o[2] = __builtin_bit_cast(float, hv.y << 16) + y0[2]; o[3] = __builtin_bit_cast(float, hv.y & 0xffff0000u) + y0[3];
                    o[4] = __builtin_bit_cast(float, hv.z << 16) + y1[0]; o[5] = __builtin_bit_cast(float, hv.z & 0xffff0000u) + y1[1]; o[6] = __builtin_bit_cast(float, hv.w << 16) + y1[2]; o[7] = __builtin_bit_cast(float, hv.w & 0xffff0000u) + y1[3];
#pragma unroll
                    for (int j = 0; j < 8; ++j) hs += o[j] * o[j];
                    if (FINAL) { float* op = OUT + (prow + rl) * 2048 + col0 + bj * HALF;
                        __builtin_nontemporal_store((f32x4){o[0], o[1], o[2], o[3]}, (f32x4*)op); __builtin_nontemporal_store((f32x4){o[4], o[5], o[6], o[7]}, (f32x4*)(op + 4)); }
                    else { u32x4 w; w.x = cvt_pk_bf16(o[0], o[1]); w.y = cvt_pk_bf16(o[2], o[3]); w.z = cvt_pk_bf16(o[4], o[5]); w.w = cvt_pk_bf16(o[6], o[7]);
                        *(u32x4*)(rowp + bj * HALF) = w; } }
                if (!FINAL) red[slot + rl] = hs; }
        if (FINAL) return;
        asm volatile("s_waitcnt lgkmcnt(0)" ::: "memory"); __builtin_amdgcn_s_barrier();
        if (tid < 256) { xst(XQ + (prow + tid) * 8 + u.pn, rowsum(tid)); asm volatile("s_waitcnt vmcnt(0)" ::: "memory"); }
        __builtin_amdgcn_s_barrier();
        if (tid == 0) { unsigned* c_ = cnt + 128 + u.pm; asm volatile("" : "+s"(c_));
            const unsigned old = xb_add(c_, 1u);
            flag[0] = old == 7u ? 1u : 0u; }
        asm volatile("s_waitcnt lgkmcnt(0)" ::: "memory"); __builtin_amdgcn_s_barrier();
        if (flag[0] != 0u && tid < 256) R2[prow + tid] = 1.0f / sqrtf(sum8x(XQ + (prow + tid) * 8) * (1.0f / 2048.0f) + 1e-6f);
        asm volatile("s_waitcnt lgkmcnt(0)" ::: "memory"); __builtin_amdgcn_s_barrier();
    }
};

template <class Epi, class Sched, bool ALIGN_EPI = false, bool SP2 = false>
__device__ __forceinline__ void gemm_phase(PG8_LAS unsigned char* lds, const Gemm g, const Sched& S, const Epi& E, const int tid) {
    const int wid = __builtin_amdgcn_readfirstlane(tid >> 6), lane = tid & 63, wr = wid >> 2, wc = wid & 3, fr = lane & 15, fq = lane >> 4;
    const int K = g.K, nt = K / BK;
    unsigned voffA[2], voffB[2];
#pragma unroll
    for (int i = 0; i < 2; ++i) { int R, C; stage_rc(tid * 16 + i * 8192, R, C); const int Rb = Epi::PERM ? ((R & ~31) + perm32(R & 31)) : R;
        voffA[i] = (unsigned)(R * K + C) * 2u; voffB[i] = (unsigned)(Rb * K + C) * 2u; }
    const size_t kstep = (size_t)(BK * 2);
    const size_t hstep = (size_t)HALF * K * 2;
    const size_t tstep = 2 * hstep;
    const unsigned ldsw = (unsigned)wid * 1024u;
    const int aoff = lds_byte(wr * 64 + fr, fq * 8), boff = lds_byte(wc * 32 + fr, fq * 8);
#define PG8_SA(b, h) (((b) * 2 + (h)) * HTB)
#define PG8_SB(b, h) ((4 + (b) * 2 + (h)) * HTB)
#define PG8_STAGE(bufoff, gbase, voff) do { _Pragma("unroll") for (int _i = 0; _i < 2; ++_i) \
        __builtin_amdgcn_global_load_lds((const unsigned*)((const char*)(gbase) + (voff)[_i]), (PG8_LAS unsigned*)(lds + (bufoff) + ldsw + _i * 8192), 16, 0, 0); } while (0)
#define PG8_LDA(dst, b, h) do { _Pragma("unroll") for (int m = 0; m < 4; ++m) _Pragma("unroll") for (int k = 0; k < 2; ++k) dst[m][k] = *(const PG8_LAS bf16x8*)(lds + PG8_SA(b, h) + aoff + m * 2048 + k * 1024); } while (0)
#define PG8_LDB(dst, b, h) do { _Pragma("unroll") for (int n = 0; n < 2; ++n) _Pragma("unroll") for (int k = 0; k < 2; ++k) dst[n][k] = *(const PG8_LAS bf16x8*)(lds + PG8_SB(b, h) + boff + n * 2048 + k * 1024); } while (0)
#define PG8_MMA(ai, bj, At, Bt) do { __builtin_amdgcn_s_setprio(1); _Pragma("unroll") for (int m = 0; m < 4; ++m) _Pragma("unroll") for (int n = 0; n < 2; ++n) _Pragma("unroll") for (int k = 0; k < 2; ++k) \
        acc[ai][bj][m][n] = __builtin_amdgcn_mfma_f32_16x16x32_bf16(Bt[n][k], At[m][k], acc[ai][bj][m][n], 0, 0, 0); __builtin_amdgcn_s_setprio(0); } while (0)
#define PG8_WAIT_V(n) asm volatile("s_waitcnt vmcnt(" #n ")" ::: "memory")
#define PG8_WAIT_L(n) asm volatile("s_waitcnt lgkmcnt(" #n ")" ::: "memory")
#define PG8_BAR __builtin_amdgcn_s_barrier()
#define PG8_SCHED __builtin_amdgcn_sched_barrier(0)
    Unit cur, nxt; int ui = 0;
    if (!S.next(0, cur)) return;
    f32x4 acc[2][2][4][2];
#pragma unroll
    for (int a = 0; a < 2; ++a)
#pragma unroll
        for (int b = 0; b < 2; ++b)
#pragma unroll
            for (int m = 0; m < 4; ++m)
#pragma unroll
                for (int n = 0; n < 2; ++n) acc[a][b][m][n] = (f32x4){0.f, 0.f, 0.f, 0.f};
    bf16x8 At[4][2], B0[2][2], B1[2][2];
    const char* cA = (const char*)g.A + (size_t)cur.pm * tstep; const char* cB = (const char*)g.Bt + (size_t)cur.pn * tstep;
    S.a_ready(cur);
    if constexpr (Epi::HAS_SCALE) E.prefetch(cur, 0, wid, lane);
    if constexpr (SP2) {
        PG8_STAGE(PG8_SB(0, 0), cB, voffB); PG8_STAGE(PG8_SB(0, 1), cB + hstep, voffB); PG8_STAGE(PG8_SA(0, 0), cA, voffA); PG8_STAGE(PG8_SA(0, 1), cA + hstep, voffA);
        if (wr == 1) PG8_BAR;
        PG8_WAIT_V(2); PG8_BAR;
        PG8_STAGE(PG8_SB(1, 0), cB + kstep, voffB); PG8_STAGE(PG8_SA(1, 0), cA + kstep, voffA); PG8_STAGE(PG8_SB(1, 1), cB + hstep + kstep, voffB);
        PG8_WAIT_V(6); PG8_BAR;
    } else {
        PG8_STAGE(PG8_SB(0, 0), cB, voffB); PG8_STAGE(PG8_SA(0, 0), cA, voffA); PG8_STAGE(PG8_SB(0, 1), cB + hstep, voffB); PG8_STAGE(PG8_SA(0, 1), cA + hstep, voffA);
        if (wr == 1) PG8_BAR;
        PG8_WAIT_V(4); PG8_BAR;
        PG8_STAGE(PG8_SB(1, 0), cB + kstep, voffB); PG8_STAGE(PG8_SA(1, 0), cA + kstep, voffA); PG8_STAGE(PG8_SB(1, 1), cB + hstep + kstep, voffB);
        PG8_WAIT_V(6); PG8_BAR;
    }
    for (;;) {
        const bool has_next = S.next(ui + 1, nxt);
        const char* nA = has_next ? (const char*)g.A + (size_t)nxt.pm * tstep : cA; const char* nB = has_next ? (const char*)g.Bt + (size_t)nxt.pn * tstep : cB;
        for (int t = 0; t < nt; t += 2) {
            const bool last = (t == nt - 2);
            const char* a1 = cA + (size_t)(t + 1) * kstep;
            const char* a2 = last ? nA : cA + (size_t)(t + 2) * kstep; const char* b2 = last ? nB : cB + (size_t)(t + 2) * kstep;
            const char* a3 = a2 + kstep; const char* b3 = b2 + kstep;
            if (last && has_next) { S.a_ready(nxt); if constexpr (Epi::HAS_SCALE) E.prefetch(nxt, (ui + 1) & 1, wid, lane); }
            if constexpr (SP2) {
            PG8_LDB(B0, 0, 0); PG8_LDB(B1, 0, 1); PG8_SCHED; PG8_LDA(At, 0, 0); PG8_STAGE(PG8_SA(1, 1), a1 + hstep, voffA);
            PG8_WAIT_V(8); PG8_WAIT_L(0); PG8_BAR; PG8_MMA(0, 0, At, B0); PG8_MMA(0, 1, At, B1); PG8_BAR; PG8_SCHED;
            PG8_LDA(At, 0, 1); PG8_STAGE(PG8_SB(0, 0), b2, voffB); PG8_STAGE(PG8_SB(0, 1), b2 + hstep, voffB); PG8_STAGE(PG8_SA(0, 0), a2, voffA);
            PG8_WAIT_V(8); PG8_WAIT_L(0); PG8_BAR; PG8_MMA(1, 0, At, B0); PG8_MMA(1, 1, At, B1); PG8_BAR; PG8_SCHED;
            PG8_LDB(B0, 1, 0); PG8_LDB(B1, 1, 1); PG8_SCHED; PG8_LDA(At, 1, 0); PG8_STAGE(PG8_SA(0, 1), a2 + hstep, voffA);
            PG8_WAIT_V(8); PG8_WAIT_L(0); PG8_BAR; PG8_MMA(0, 0, At, B0); PG8_MMA(0, 1, At, B1); PG8_BAR; PG8_SCHED;
            PG8_LDA(At, 1, 1); PG8_STAGE(PG8_SB(1, 0), b3, voffB); PG8_STAGE(PG8_SB(1, 1), b3 + hstep, voffB); PG8_STAGE(PG8_SA(1, 0), a3, voffA);
            PG8_WAIT_V(8); PG8_WAIT_L(0); PG8_BAR; PG8_MMA(1, 0, At, B0); PG8_MMA(1, 1, At, B1); PG8_BAR; PG8_SCHED;
            } else {
            PG8_LDB(B0, 0, 0); PG8_SCHED; PG8_LDA(At, 0, 0); PG8_STAGE(PG8_SA(1, 1), a1 + hstep, voffA);
            PG8_WAIT_L(8); PG8_BAR; PG8_WAIT_L(0); PG8_MMA(0, 0, At, B0); PG8_BAR; PG8_SCHED;
            PG8_LDB(B1, 0, 1); PG8_STAGE(PG8_SB(0, 0), b2, voffB);
            PG8_BAR; PG8_WAIT_L(0); PG8_MMA(0, 1, At, B1); PG8_BAR;
            PG8_LDA(At, 0, 1); PG8_STAGE(PG8_SA(0, 0), a2, voffA);
            PG8_BAR; PG8_WAIT_L(0); PG8_MMA(1, 0, At, B0); PG8_BAR; PG8_SCHED;
            PG8_STAGE(PG8_SB(0, 1), b2 + hstep, voffB);
            PG8_WAIT_V(6); PG8_BAR; PG8_MMA(1, 1, At, B1); PG8_BAR;
            PG8_LDB(B0, 1, 0); PG8_SCHED; PG8_LDA(At, 1, 0); PG8_STAGE(PG8_SA(0, 1), a2 + hstep, voffA);
            PG8_WAIT_L(8); PG8_BAR; PG8_WAIT_L(0); PG8_MMA(0, 0, At, B0); PG8_BAR; PG8_SCHED;
            PG8_LDB(B1, 1, 1); PG8_STAGE(PG8_SB(1, 0), b3, voffB);
            PG8_BAR; PG8_WAIT_L(0); PG8_MMA(0, 1, At, B1); PG8_BAR;
            PG8_LDA(At, 1, 1); PG8_STAGE(PG8_SA(1, 0), a3, voffA);
            PG8_BAR; PG8_WAIT_L(0); PG8_MMA(1, 0, At, B0); PG8_BAR; PG8_SCHED;
            PG8_STAGE(PG8_SB(1, 1), b3 + hstep, voffB);
            PG8_WAIT_V(6); PG8_BAR; PG8_MMA(1, 1, At, B1); PG8_BAR;
            }
        }
        if constexpr (ALIGN_EPI) { if (wr == 0) PG8_BAR; }
        if constexpr (!Epi::AFTER_DRAIN) { E(acc, cur, wr, wc, fr, fq, ui & 1); S.done(cur); }
        if (!has_next) break;
#pragma unroll
        for (int a = 0; a < 2; ++a)
#pragma unroll
            for (int b = 0; b < 2; ++b)
#pragma unroll
                for (int m = 0; m < 4; ++m)
#pragma unroll
                    for (int n = 0; n < 2; ++n) acc[a][b][m][n] = (f32x4){0.f, 0.f, 0.f, 0.f};
        cur = nxt; cA = nA; cB = nB; ++ui;
        if constexpr (ALIGN_EPI) { if (wr == 1) PG8_BAR; }
    }
    PG8_WAIT_V(0);
    if constexpr (!ALIGN_EPI) { if (wr == 0) PG8_BAR; }
    PG8_BAR;
#undef PG8_SA
#undef PG8_SB
#undef PG8_STAGE
#undef PG8_LDA
#undef PG8_LDB
#undef PG8_MMA
#undef PG8_WAIT_V
#undef PG8_WAIT_L
#undef PG8_BAR
#undef PG8_SCHED
}
}

#define XB_TMO      128
#define XB_XCNT(j)  (256  + 64 * (j))
#define XB_XSUB(j)  (1280 + 64 * (j))
#define XB_XGEN(j)  (2304 + 64 * (j))
#define XB_TOP      3328
#define XB_TOPGEN   3392
#define XCD_BAR_WORDS 3456
#define XB_SPIN_CAP (1u << 27)
__device__ __forceinline__ unsigned xb_ld(unsigned* p)              { return __hip_atomic_load(p, __ATOMIC_RELAXED, __HIP_MEMORY_SCOPE_AGENT); }
__device__ __forceinline__ unsigned xb_add(unsigned* p, unsigned v) { return __hip_atomic_fetch_add(p, v, __ATOMIC_RELAXED, __HIP_MEMORY_SCOPE_AGENT); }
__device__ __forceinline__ unsigned xb_xcc_id() { return (unsigned)__builtin_amdgcn_s_getreg((3 << 11) | 20) & 0xFu; }
#define XB_SPIN(cond, bar) do { unsigned _sp = 0; while (cond) { __builtin_amdgcn_s_sleep(1); \
    if ((++_sp & 255u) == 0u) { if (xb_ld(&(bar)[XB_TMO])) break; if (_sp > XB_SPIN_CAP) { atomicAdd(&(bar)[XB_TMO], 1u); break; } } } } while (0)
struct XcdBarrier { unsigned* bar; unsigned x; volatile LAS unsigned* st; };
__device__ __forceinline__ XcdBarrier xcd_barrier_post(unsigned* bar, volatile LAS unsigned* st) {
    XcdBarrier b; b.bar = bar; b.x = xb_xcc_id(); b.st = st;
    if (threadIdx.x == 0) (void)xb_add(&bar[XB_XCNT(b.x)], 1u);
    return b;
}
__device__ __forceinline__ void xcd_barrier_complete(unsigned* bar, unsigned x, unsigned& nloc, unsigned& nx) {
    const unsigned G = gridDim.x * gridDim.y * gridDim.z;
    unsigned sum, cnt, mine, sp = 0u;
    for (;;) {
        sum = 0u; cnt = 0u; mine = 0u;
#pragma unroll
        for (unsigned j = 0; j < 16; ++j) { const unsigned c = xb_ld(&bar[XB_XCNT(j)]); sum += c; cnt += (c > 0u) ? 1u : 0u; mine = (j == x) ? c : mine; }
        if (sum == G) break;
        __builtin_amdgcn_s_sleep(1);
        if ((++sp & 255u) == 0u) { if (xb_ld(&bar[XB_TMO])) break; if (sp > XB_SPIN_CAP) { atomicAdd(&bar[XB_TMO], 1u); break; } }
    }
    nloc = mine > 0u ? mine : 1u; nx = cnt > 0u ? cnt : 1u;
}
__device__ __forceinline__ void xcd_barrier(const XcdBarrier& b) {
    asm volatile("s_waitcnt vmcnt(0)" ::: "memory");
    __syncthreads();
    if (threadIdx.x == 0) {
        unsigned* bar = b.bar; asm volatile("" : "+s"(bar));
        __builtin_amdgcn_s_waitcnt(0);
        unsigned nloc = b.st[0], nx = b.st[1];
        if (nloc == 0u) { xcd_barrier_complete(bar, b.x, nloc, nx); b.st[0] = nloc; b.st[1] = nx; }
        const unsigned old = xb_add(&bar[XB_XSUB(b.x)], 1u);
        const unsigned gen = old / nloc;
        if (old + 1u == (gen + 1u) * nloc) {
            __builtin_amdgcn_fence(__ATOMIC_RELEASE, "agent");
            asm volatile("s_waitcnt vmcnt(0)" ::: "memory");
            const unsigned og = xb_add(&bar[XB_TOP], 1u);
            const unsigned tg = og / nx;
            if (og + 1u == (tg + 1u) * nx) xb_add(&bar[XB_TOPGEN], 1u);
            else XB_SPIN(xb_ld(&bar[XB_TOPGEN]) == tg, bar);
            __builtin_amdgcn_fence(__ATOMIC_ACQUIRE, "agent");
            xb_add(&bar[XB_XGEN(b.x)], 1u);
            asm volatile("s_waitcnt vmcnt(0)" ::: "memory");
        } else {
            XB_SPIN(xb_ld(&bar[XB_XGEN(b.x)]) == gen, bar);
            __builtin_amdgcn_fence(__ATOMIC_ACQUIRE, "agent");
            asm volatile("s_waitcnt vmcnt(0)" ::: "memory");
        }
    }
    __syncthreads();
}

#ifndef SIMPLE_GEMM
#define SIMPLE_GEMM 0
#endif
#ifndef MK_N_LAUNCHES
#define MK_N_LAUNCHES 1
#endif
constexpr int N_PHASES = 8 * kL + 1;
constexpr int RING_BYTES = 131072, LDS_BYTES = 163840, MISC_OFF = LDS_BYTES - 256;
static_assert(3 * CL_BYTES <= MISC_OFF && SL_END <= MISC_OFF && PL_END <= MISC_OFF, "lds map");
constexpr int CW_BAR = 4096;
constexpr int CW_CNT = CW_BAR + XCD_BAR_WORDS, CNT_WORDS = 2 * kL * 256;
#ifndef FUSE_NORM
#define FUSE_NORM 1
#endif
__global__ void __launch_bounds__(512, 2) fwd_kernel(Args args) {
    extern __shared__ __attribute__((aligned(16))) unsigned char lds[];
    Frame F;
    F.lds = (LAS unsigned char*)lds;
    F.tid = threadIdx.x; F.lane = F.tid & 63; F.wave = __builtin_amdgcn_readfirstlane(F.tid >> 6); F.G = gridDim.x; F.bid = blockIdx.x;
    int wave_s = F.wave; asm volatile("" : "+s"(wave_s));
    F.ka = ka_fresh();
    unsigned char* ws = args.ws;
    volatile LAS unsigned* MISC = (volatile LAS unsigned*)(F.lds + MISC_OFF);
    if (F.tid < 32) MISC[F.tid] = 0u;
    __syncthreads();
    const int lo = args.ph_lo, hi = args.ph_hi;
    XcdBarrier bar; bar.bar = (unsigned*)(ws + WS_CTL) + CW_BAR; bar.x = 0; bar.st = nullptr;
    if (hi - lo > 1) bar = xcd_barrier_post((unsigned*)(ws + WS_CTL) + CW_BAR, MISC + 8);
#ifndef PHMASK
#define PHMASK 0xFFFF
#endif
#define IN(p) (lo <= (p) && (p) < hi)
#define PHASE_BEGIN() do { F.ka = ka_fresh(); int tz_; asm volatile("v_mbcnt_lo_u32_b32 %0, -1, 0\n\tv_mbcnt_hi_u32_b32 %0, -1, %0" : "=v"(tz_)); tz_ += wave_s * 64; F.tid = tz_; F.lane = tz_ & 63; F.wave = __builtin_amdgcn_readfirstlane(tz_ >> 6); } while (0)
#define EN(k) ((PHMASK >> (k)) & 1)
#ifndef REPMASK
#define REPMASK 0
#endif
#define REP(k) (1 + ((REPMASK >> (k)) & 1))
#define SEAM(p) do { if (IN(p) && IN((p) + 1)) xcd_barrier(bar); else __syncthreads(); } while (0)
#pragma unroll 1
    for (int l = 0; l < kL; ++l) {
        const int p0 = 8 * l;
        if (IN(p0)) { PHASE_BEGIN();
            if (EN(0)) { if (l == 0) { init_phase(F); norm_phase<0>(F, nullptr, 4);
                if (F.wave >= 4) for (int it = F.bid * 4 + (F.wave - 4); it < CV_N0 + CV_N1; it += F.G * 4) conv_wave_tile(F, 0, it, F.lane); }
            else if (!FUSE_NORM) norm_phase<1>(F, F.in(I_NQF) + (l - 1) * kD); }
        }
        if (l == 0 || !FUSE_NORM) SEAM(p0);
        if (EN(2) && IN(p0 + 1) && (SIMPLE_GEMM & 1)) { PHASE_BEGIN(); simple_gemm_phase<0>(F, F.HB(), F.WinT(l), kM, kNP, kD, F.P(), kNP); }
        else if (EN(2) && IN(p0 + 1)) { PHASE_BEGIN(); pg8::Gemm g{F.HB(), F.WinT(l), kM, kNP, kD}; pg8::StaticOrder S; S.init(kM, kNP, F.G, F.bid); pg8::EpiBf16<true> E{F.P(), kNP, F.R2(), (LAS float*)(F.lds + RING_BYTES)};
            pg8::gemm_phase<pg8::EpiBf16<true>, pg8::StaticOrder, true, true>(F.lds, g, S, E, F.tid); }
        SEAM(p0 + 1);
        for (int rep_ = 0; rep_ < REP(3); ++rep_) { if (EN(3) && IN(p0 + 2)) { PHASE_BEGIN(); prep_phase(F, l); } }
        SEAM(p0 + 2);
        for (int rep_ = 0; rep_ < REP(4); ++rep_) { if (EN(4) && IN(p0 + 3)) { PHASE_BEGIN(); mix_phase(F, l); } }
        SEAM(p0 + 3);
        if (EN(5) && IN(p0 + 4) && (SIMPLE_GEMM & 2)) { PHASE_BEGIN(); simple_gemm_phase<0>(F, F.O(), F.WoutT(l), kM, kD, kD, F.Y(), kD); }
        else if (EN(5) && IN(p0 + 4) && FUSE_NORM) { PHASE_BEGIN(); pg8::Gemm g{F.O(), F.WoutT(l), kM, kD, kD}; pg8::PanelOrder S; S.init(kM, F.G, F.bid);
            float* xp = (float*)(F.ws() + WS_Y + 160 * MiB); unsigned* ctl = (unsigned*)(F.ws() + WS_CTL);
            pg8::EpiResNorm<false> E{nullptr, F.HB(), F.in(I_NQM) + l * kD, xp, xp + (size_t)kM * 8, F.R2(), ctl + CW_CNT + (2 * l) * 256, ctl + CW_BAR + XB_TMO, (LAS float*)(F.lds + RING_BYTES)};
            pg8::gemm_phase<pg8::EpiResNorm<false>, pg8::PanelOrder, true, true>(F.lds, g, S, E, F.tid); }
        else if (EN(5) && IN(p0 + 4)) { PHASE_BEGIN(); pg8::Gemm g{F.O(), F.WoutT(l), kM, kD, kD}; pg8::StaticOrder S; S.init(kM, kD, F.G, F.bid); pg8::EpiBf16<false> E{F.Y(), kD, nullptr, nullptr};
            pg8::gemm_phase<pg8::EpiBf16<false>, pg8::StaticOrder, true, true>(F.lds, g, S, E, F.tid); }
        SEAM(p0 + 4);
        if (!FUSE_NORM) { if (EN(6) && IN(p0 + 5)) { PHASE_BEGIN(); norm_phase<1>(F, F.in(I_NQM) + l * kD); }
        SEAM(p0 + 5); }
        if (EN(7) && IN(p0 + 6) && (SIMPLE_GEMM & 4)) { PHASE_BEGIN(); simple_gemm_phase<1>(F, F.HB(), F.WguT(l), kM, 2 * kFF, kD, F.P(), kFF); }
        else if (EN(7) && IN(p0 + 6)) { PHASE_BEGIN(); pg8::Gemm g{F.HB(), F.WguT(l), kM, 2 * kFF, kD}; pg8::StaticOrder S; S.init(kM, 2 * kFF, F.G, F.bid); pg8::EpiSwiGlu E{F.P(), kFF, F.R2(), (LAS float*)(F.lds + RING_BYTES)};
            pg8::gemm_phase<pg8::EpiSwiGlu, pg8::StaticOrder, true, true>(F.lds, g, S, E, F.tid); }
        SEAM(p0 + 6);
        if (EN(8) && IN(p0 + 7) && (SIMPLE_GEMM & 8)) { PHASE_BEGIN(); simple_gemm_phase<0>(F, F.P(), F.WdT(l), kM, kD, kFF, F.Y(), kD); }
        else if (EN(8) && IN(p0 + 7) && FUSE_NORM && l + 1 < kL) { PHASE_BEGIN(); pg8::Gemm g{F.P(), F.WdT(l), kM, kD, kFF}; pg8::PanelOrder S; S.init(kM, F.G, F.bid);
            float* xp = (float*)(F.ws() + WS_Y + 160 * MiB); unsigned* ctl = (unsigned*)(F.ws() + WS_CTL);
            pg8::EpiResNorm<false> E{nullptr, F.HB(), F.in(I_NQF) + l * kD, xp, xp + (size_t)kM * 8, F.R2(), ctl + CW_CNT + (2 * l + 1) * 256, ctl + CW_BAR + XB_TMO, (LAS float*)(F.lds + RING_BYTES)};
            pg8::gemm_phase<pg8::EpiResNorm<false>, pg8::PanelOrder, true, true>(F.lds, g, S, E, F.tid); }
        else if (EN(8) && IN(p0 + 7) && FUSE_NORM) { PHASE_BEGIN(); pg8::Gemm g{F.P(), F.WdT(l), kM, kD, kFF}; pg8::PanelOrder S; S.init(kM, F.G, F.bid);
            float* xp = (float*)(F.ws() + WS_Y + 160 * MiB); unsigned* ctl = (unsigned*)(F.ws() + WS_CTL);
            pg8::EpiResNorm<true> E{F.out(), F.HB(), F.in(I_NQF) + l * kD, xp, xp + (size_t)kM * 8, F.R2(), ctl + CW_CNT + (2 * l + 1) * 256, ctl + CW_BAR + XB_TMO, (LAS float*)(F.lds + RING_BYTES)};
            pg8::gemm_phase<pg8::EpiResNorm<true>, pg8::PanelOrder, true, true>(F.lds, g, S, E, F.tid); }
        else if (EN(8) && IN(p0 + 7)) { PHASE_BEGIN(); pg8::Gemm g{F.P(), F.WdT(l), kM, kD, kFF}; pg8::StaticOrder S; S.init(kM, kD, F.G, F.bid); pg8::EpiBf16<false> E{F.Y(), kD, nullptr, nullptr};
            pg8::gemm_phase<pg8::EpiBf16<false>, pg8::StaticOrder, true, true>(F.lds, g, S, E, F.tid); }
        if (!FUSE_NORM || l + 1 < kL) SEAM(p0 + 7);
    }
    if (!FUSE_NORM && IN(8 * kL)) { PHASE_BEGIN(); norm_phase<2>(F, F.in(I_NQF) + (kL - 1) * kD); }
#undef IN
#undef SEAM
}

extern "C" void kernel_launch(void* const* d_in, const int* in_sizes, int n_in, void* d_out, int out_size, void* d_ws, size_t ws_size, hipStream_t stream) {
    static int grid = 0;
    if (grid == 0) {
        if (n_in != 31 || out_size != kM * kD || ws_size < WS_END) { fprintf(stderr, "kernel_launch: unexpected shapes (n_in %d out %d ws %zu need %zu)\n", n_in, out_size, ws_size, (size_t)WS_END); grid = -1; return; }
        int dev = 0, cus = 0, per_cu = 0;
        if (hipGetDevice(&dev) != hipSuccess || hipDeviceGetAttribute(&cus, hipDeviceAttributeMultiprocessorCount, dev) != hipSuccess) { grid = -1; return; }
        if (hipFuncSetAttribute((const void*)fwd_kernel, hipFuncAttributeMaxDynamicSharedMemorySize, LDS_BYTES) != hipSuccess) { fprintf(stderr, "kernel_launch: hipFuncSetAttribute failed\n"); grid = -1; return; }
        if (hipOccupancyMaxActiveBlocksPerMultiprocessor(&per_cu, (const void*)fwd_kernel, 512, LDS_BYTES) != hipSuccess || per_cu < 1) { fprintf(stderr, "kernel_launch: occupancy query says %d\n", per_cu); }
        (void)hipGetLastError();
        grid = cus;
    }
    if (grid < 0) return;
    (void)hipMemsetAsync((char*)d_ws + WS_CTL + (size_t)CW_BAR * 4, 0, (size_t)(XCD_BAR_WORDS + CNT_WORDS) * 4, stream);
    Args a{};
    for (int i = 0; i < 31; ++i) a.in[i] = (const float*)d_in[i];
    a.out = (float*)d_out; a.ws = (unsigned char*)d_ws;
    constexpr int NL = MK_N_LAUNCHES;
    for (int li = 0; li < NL; ++li) {
        a.ph_lo = (int)((long)N_PHASES * li / NL); a.ph_hi = (int)((long)N_PHASES * (li + 1) / NL);
        hipLaunchKernelGGL(fwd_kernel, dim3(grid), dim3(512), LDS_BYTES, stream, a);
    }
}
#endif
```

```cpp
#ifndef HOST_EMU
#include <hip/hip_runtime.h>
#include <cstdio>
#include <cstdint>
#endif

#ifndef BATCH
#define BATCH 16
#endif
#ifndef SEQ
#define SEQ 2048
#endif
constexpr int kB = BATCH, kS = SEQ, kM = kB * kS, kD = 2048, kL = 4, kG = 512, kH = 8, kHD = 64, kFF = 5632;
constexpr int kNIN = 7952, kNP = 8192;
constexpr int PC_RET = 0, PC_HG = 2048, PC_ML = 4096, PC_RW = 6144, PC_MLG = 7936;
constexpr int kRWS = 3584;
constexpr int RS_R = 0, RS_W = 512, RS_K = 1024, RS_V = 1536, RS_KK = 2048, RS_B = 2560, RS_G = 3072;
constexpr float kNormEps = 1e-6f, kRwkvLnEps = 64e-5f, kDecayScale = 0.6065306597126334f;

typedef unsigned short u16;
typedef short bf16x8 __attribute__((ext_vector_type(8)));
typedef float f32x4 __attribute__((ext_vector_type(4)));
typedef unsigned u32x4 __attribute__((ext_vector_type(4)));
typedef unsigned u32x2 __attribute__((ext_vector_type(2)));

#ifndef HOST_EMU
#define DEV __device__ __forceinline__
#define MDEV __device__ __forceinline__
#define LAS __attribute__((address_space(3)))
DEV f32x4 mfma16(bf16x8 a, bf16x8 b, f32x4 c) { return __builtin_amdgcn_mfma_f32_16x16x32_bf16(a, b, c, 0, 0, 0); }
template <int CTRL> DEV float dppf(float x) { return __builtin_bit_cast(float, __builtin_amdgcn_mov_dpp(__builtin_bit_cast(int, x), CTRL, 0xf, 0xf, true)); }
DEV float lx1(float x) { return dppf<0xB1>(x); }
DEV float lx2(float x) { return dppf<0x4E>(x); }
DEV float lm8(float x) { return dppf<0x141>(x); }
DEV float lr8(float x) { return dppf<0x128>(x); }
template <int CTRL, int RM> DEV float dppz(float x) { return __builtin_bit_cast(float, __builtin_amdgcn_update_dpp(0, __builtin_bit_cast(int, x), CTRL, RM, 0xf, true)); }
DEV float scan32(float v) { v += dppz<0x111, 0xf>(v); v += dppz<0x112, 0xf>(v); v += dppz<0x114, 0xf>(v); v += dppz<0x118, 0xf>(v); v += dppz<0x142, 0xa>(v); return v; }
DEV float xswap32(float x, bool lower) { auto t = __builtin_amdgcn_permlane32_swap(__builtin_bit_cast(unsigned, x), __builtin_bit_cast(unsigned, x), false, false); return __builtin_bit_cast(float, lower ? t[1] : t[0]); }
DEV float lxany(float x, int lane, int m) { return __builtin_bit_cast(float, __builtin_amdgcn_ds_bpermute((lane ^ m) << 2, __builtin_bit_cast(int, x))); }
DEV float rdlane(float x, int i) { return __builtin_bit_cast(float, __builtin_amdgcn_readlane(__builtin_bit_cast(int, x), i)); }
DEV void wave_sync() { asm volatile("s_waitcnt lgkmcnt(0)" ::: "memory"); __builtin_amdgcn_wave_barrier(); }
DEV void wait_vm0() { asm volatile("s_waitcnt vmcnt(0)" ::: "memory"); }
DEV void lds_sync() { asm volatile("s_waitcnt lgkmcnt(0)" ::: "memory"); __builtin_amdgcn_s_barrier(); }
DEV void glds16(const u16* g, LAS u16* lbase, int) { __builtin_amdgcn_global_load_lds((const unsigned*)g, (LAS unsigned*)lbase, 16, 0, 2); }
typedef float f32x2_ __attribute__((ext_vector_type(2)));
typedef __bf16 bf16x2_ __attribute__((ext_vector_type(2)));
DEV unsigned cvtpk(float lo, float hi) { const f32x2_ v = {lo, hi}; return __builtin_bit_cast(unsigned, __builtin_convertvector(v, bf16x2_)); }
DEV float fexp(float x) { return __expf(x); }
DEV float frcp(float x) { return __builtin_amdgcn_rcpf(x); }
DEV float frsq(float x) { return __builtin_amdgcn_rsqf(x); }
DEV float sin_rev(float fr) { return __builtin_amdgcn_sinf(fr); }
DEV float cos_rev(float fr) { return __builtin_amdgcn_cosf(fr); }
#endif

DEV float sum8(float x) { x += lx1(x); x += lx2(x); x += lm8(x); return x; }
DEV float sum16(float x) { x = sum8(x); x += lr8(x); return x; }
DEV float sum64(float v) { const float r = sum16(v); return (rdlane(r, 0) + rdlane(r, 16)) + (rdlane(r, 32) + rdlane(r, 48)); }

DEV u16 f2bf(float f) { unsigned u = __builtin_bit_cast(unsigned, f); return (u16)((u + 0x7fffu + ((u >> 16) & 1u)) >> 16); }
DEV float bf2f(u16 b) { return __builtin_bit_cast(float, ((unsigned)b) << 16); }
DEV unsigned pk2(float lo, float hi) { return (unsigned)f2bf(lo) | ((unsigned)f2bf(hi) << 16); }
DEV float sigm(float x) { return 1.0f / (1.0f + expf(-x)); }
DEV float fsig(float x) { return frcp(1.0f + fexp(-x)); }
DEV float logsig(float x) { return fminf(x, 0.f) - log1pf(expf(-fabsf(x))); }
DEV void unpack8(u32x4 v, float* o) {
    o[0] = bf2f((u16)(v.x & 0xffff)); o[1] = bf2f((u16)(v.x >> 16)); o[2] = bf2f((u16)(v.y & 0xffff)); o[3] = bf2f((u16)(v.y >> 16));
    o[4] = bf2f((u16)(v.z & 0xffff)); o[5] = bf2f((u16)(v.z >> 16)); o[6] = bf2f((u16)(v.w & 0xffff)); o[7] = bf2f((u16)(v.w >> 16));
}
DEV u32x4 pack8(const float* o) { u32x4 v; v.x = pk2(o[0], o[1]); v.y = pk2(o[2], o[3]); v.z = pk2(o[4], o[5]); v.w = pk2(o[6], o[7]); return v; }

constexpr size_t MiB = 1u << 20;
constexpr size_t al1m(size_t x) { return (x + MiB - 1) / MiB * MiB; }
constexpr size_t WS_CTL = 0, CTL_ZERO_BYTES = 1 * MiB;
constexpr size_t WS_TRIG = 1 * MiB;
constexpr size_t WS_R2 = 1 * MiB + 512 * 1024;
constexpr size_t WS_SW = 2 * MiB;
constexpr int SW_WUP = 0, SW_AUP = 512 * 64, SW_GUP = 2 * 512 * 64, SW_VDN = SW_GUP + 512 * 128, SW_VUP = SW_VDN + 32 * 512, SW_LAYER = SW_VUP + 512 * 32;
constexpr size_t WS_W = 4 * MiB;
constexpr size_t WO_IN = 0, WO_OUT = (size_t)kNP * kD * 2, WO_GU = WO_OUT + (size_t)kD * kD * 2, WO_DN = WO_GU + (size_t)2 * kFF * kD * 2, WO_END = WO_DN + (size_t)kD * kFF * 2;
constexpr size_t WS_U = WS_W + al1m(WO_END);
constexpr size_t WS_P = WS_U + al1m((size_t)kM * kD * 2);
constexpr size_t WS_Y = WS_P + al1m((size_t)kM * kNP * 2);
constexpr size_t WS_VF = WS_Y + al1m((size_t)kM * kRWS * 2);
constexpr size_t WS_END = WS_VF + al1m((size_t)kM * kG * 2);

struct Args { const float* in[31]; float* out; unsigned char* ws; int ph_lo, ph_hi; };
#ifndef HOST_EMU
typedef const __attribute__((address_space(4))) Args* KArgs;
DEV KArgs ka_fresh() { KArgs p = (KArgs)__builtin_amdgcn_kernarg_segment_ptr(); asm volatile("" : "+s"(p)); return p; }
#else
typedef const Args* KArgs;
#endif
struct Frame {
    LAS unsigned char* lds;
    int tid, lane, wave, G, bid;
    KArgs ka;
    MDEV const float* in(int i) const { return ka->in[i]; }
    MDEV float* out() const { return ka->out; }
    MDEV unsigned char* ws() const { return ka->ws; }
    MDEV u16* HB() const { return (u16*)(ws() + WS_U); }
    MDEV u16* O() const { return (u16*)out(); }
    MDEV float* R2() const { return (float*)(ws() + WS_R2); }
    MDEV u16* P() const { return (u16*)(ws() + WS_P); }
    MDEV u16* Y() const { return (u16*)(ws() + WS_Y); }
    MDEV u16* RWS() const { return (u16*)(ws() + WS_Y); }
    MDEV u16* VF() const { return (u16*)(ws() + WS_VF); }
    MDEV unsigned char* wbase(int l) const { return (l & 1) ? ws() + WS_W : (unsigned char*)out() + (size_t)kM * kD * 2; }
    MDEV u16* WinT(int l) const { return (u16*)(wbase(l) + WO_IN); }
    MDEV u16* WoutT(int l) const { return (u16*)(wbase(l) + WO_OUT); }
    MDEV u16* WguT(int l) const { return (u16*)(wbase(l) + WO_GU); }
    MDEV u16* WdT(int l) const { return (u16*)(wbase(l) + WO_DN); }
    MDEV u16* SW() const { return (u16*)(ws() + WS_SW); }
    MDEV float* TRIG() const { return (float*)(ws() + WS_TRIG); }
};
enum { I_X = 0, I_WIN, I_WOUT, I_NPM, I_NQM, I_NPF, I_NQF, I_WG, I_WU, I_WD, I_HLB, I_HNW, I_MCW, I_MCB, I_MIB, I_MFB, I_MNW, I_MU, I_W0, I_WUP, I_A0, I_AUP, I_GUP, I_KK, I_KA, I_RK, I_LNW, I_LNB, I_V0, I_VDN, I_VUP };

DEV void init_phase(Frame& F) {
    const int gt = F.bid * 512 + F.tid, NT = F.G * 512;
    for (int i = gt; i < kS * 32; i += NT) {
        const int pos = i >> 5, j = i & 31;
        const float invf = powf(10000.0f, -(float)j / 32.0f);
        const float ang = (float)pos * invf;
        const double rev = (double)ang * 0.15915494309189535;
        const float fr = (float)(rev - floor(rev));
        F.TRIG()[2 * i] = cos_rev(fr); F.TRIG()[2 * i + 1] = sin_rev(fr);
    }
    for (int i = gt; i < kL * SW_LAYER; i += NT) {
        const int l = i / SW_LAYER, r = i % SW_LAYER; float v;
        if (r < SW_AUP) { const int n = r / 64, k = r % 64; v = F.in(I_WUP)[((size_t)l * 64 + k) * 512 + n]; }
        else if (r < SW_GUP) { const int q = r - SW_AUP, n = q / 64, k = q % 64; v = F.in(I_AUP)[((size_t)l * 64 + k) * 512 + n]; }
        else if (r < SW_VDN) { const int q = r - SW_GUP, n = q / 128, k = q % 128; v = F.in(I_GUP)[((size_t)l * 128 + k) * 512 + n]; }
        else if (r < SW_VUP) { const int q = r - SW_VDN, n = q / 512, k = q % 512; v = l > 0 ? F.in(I_VDN)[((size_t)(l - 1) * 512 + k) * 32 + n] : 0.f; }
        else { const int q = r - SW_VUP, n = q / 32, k = q % 32; v = l > 0 ? F.in(I_VUP)[((size_t)(l - 1) * 32 + k) * 512 + n] : 0.f; }
        F.SW()[i] = f2bf(v);
    }
}

DEV void conv_item(Frame& F, int l, int mat, int nb, int kb) {
    LAS float* tile = (LAS float*)F.lds;
    const int nn = F.tid & 63, k8 = F.tid >> 6;
    const int n = nb * 64 + nn;
    const float* src; int ld, sc; bool ok = true; int K; const float* gk = nullptr;
    if (mat == 0) { K = kD; ld = kNIN; src = F.in(I_WIN) + (size_t)l * kD * kNIN; gk = F.in(I_NPM) + l * kD;
        if (n < PC_RW) sc = n; else if (n < PC_MLG) sc = n + 16; else if (n < PC_MLG + 16) sc = n - PC_MLG + 6144; else { sc = 0; ok = false; } }
    else if (mat == 1) { K = kD; ld = kD; src = F.in(I_WOUT) + (size_t)l * kD * kD; sc = n; }
    else if (mat == 2) { K = kD; ld = kFF; gk = F.in(I_NPF) + l * kD; const int pn = n >> 8, w = n & 255; src = (w < 128 ? F.in(I_WG) : F.in(I_WU)) + (size_t)l * kD * kFF; sc = pn * 128 + (w & 127); }
    else { K = kFF; ld = kD; src = F.in(I_WD) + (size_t)l * kFF * kD; sc = n; }
#pragma unroll
    for (int i = 0; i < 8; ++i) { const int kk = k8 + 8 * i; float v = ok ? __builtin_nontemporal_load(src + (size_t)(kb * 64 + kk) * ld + sc) : 0.f; if (gk) v *= gk[kb * 64 + kk]; tile[kk * 65 + nn] = v; }
    __syncthreads();
    u16* dst = mat == 0 ? F.WinT(l) : mat == 1 ? F.WoutT(l) : mat == 2 ? F.WguT(l) : F.WdT(l);
    const int rn = F.tid >> 3, kc = F.tid & 7;
    float o[8];
#pragma unroll
    for (int j = 0; j < 8; ++j) o[j] = tile[(8 * kc + j) * 65 + rn];
    *(u32x4*)(dst + (size_t)(nb * 64 + rn) * K + kb * 64 + 8 * kc) = pack8(o);
    __syncthreads();
}
DEV void conv_phase(Frame& F, int l, bool first_only) {
    constexpr int KB2 = kD / 64, KB3 = kFF / 64;
    constexpr int N0 = (kNP / 64) * KB2, N1 = (kD / 64) * KB2, N2 = (2 * kFF / 64) * KB2, N3 = (kD / 64) * KB3;
    for (int it = F.bid; it < N0 + N1 + (first_only ? 0 : N2 + N3); it += F.G) {
        int r = it;
        if (r < N0) { conv_item(F, l, 0, r / KB2, r % KB2); continue; } r -= N0;
        if (r < N1) { conv_item(F, l, 1, r / KB2, r % KB2); continue; } r -= N1;
        if (r < N2) { conv_item(F, l, 2, r / KB2, r % KB2); continue; } r -= N2;
        conv_item(F, l, 3, r / KB3, r % KB3);
    }
}


constexpr int CV_KB2 = kD / 64, CV_KB3 = kFF / 64;
constexpr int CV_N0 = (kNP / 64) * CV_KB2, CV_N1 = (kD / 64) * CV_KB2, CV_N2 = (2 * kFF / 64) * CV_KB2, CV_N3 = (kD / 64) * CV_KB3, CV_NT = CV_N0 + CV_N1 + CV_N2 + CV_N3;
DEV void conv_wave_tile(Frame& F, int l, int it, int lane) {
    int mat, nb, kb; int r = it;
    if (r < CV_N0) { mat = 0; nb = r / CV_KB2; kb = r % CV_KB2; } else { r -= CV_N0;
    if (r < CV_N1) { mat = 1; nb = r / CV_KB2; kb = r % CV_KB2; } else { r -= CV_N1;
    if (r < CV_N2) { mat = 2; nb = r / CV_KB2; kb = r % CV_KB2; } else { r -= CV_N2; mat = 3; nb = r / CV_KB3; kb = r % CV_KB3; } } }
    const int n = nb * 64 + lane;
    const float* src; int ld, sc; bool ok = true; int K; const float* gk = nullptr; u16* dst;
    if (mat == 0) { K = kD; ld = kNIN; src = F.in(I_WIN) + (size_t)l * kD * kNIN; gk = F.in(I_NPM) + l * kD; dst = F.WinT(l);
        if (n < PC_RW) sc = n; else if (n < PC_MLG) sc = n + 16; else if (n < PC_MLG + 16) sc = n - PC_MLG + 6144; else { sc = 0; ok = false; } }
    else if (mat == 1) { K = kD; ld = kD; src = F.in(I_WOUT) + (size_t)l * kD * kD; sc = n; dst = F.WoutT(l); }
    else if (mat == 2) { K = kD; ld = kFF; gk = F.in(I_NPF) + l * kD; const int pn = n >> 8, w = n & 255; src = (w < 128 ? F.in(I_WG) : F.in(I_WU)) + (size_t)l * kD * kFF; sc = pn * 128 + (w & 127); dst = F.WguT(l); }
    else { K = kFF; ld = kD; src = F.in(I_WD) + (size_t)l * kFF * kD; sc = n; dst = F.WdT(l); }
    const float* sp = src + (size_t)(kb * 64) * ld + sc;
#pragma unroll 1
    for (int half = 0; half < 2; ++half) {
        float v[32];
#pragma unroll
        for (int i = 0; i < 32; ++i) v[i] = ok ? __builtin_nontemporal_load(sp + (size_t)(32 * half + i) * ld) : 0.f;
        if (gk) {
#pragma unroll
            for (int i = 0; i < 32; ++i) v[i] *= gk[kb * 64 + 32 * half + i]; }
#pragma unroll
        for (int g = 0; g < 4; ++g) { u32x4 o; o.x = cvtpk(v[8 * g], v[8 * g + 1]); o.y = cvtpk(v[8 * g + 2], v[8 * g + 3]); o.z = cvtpk(v[8 * g + 4], v[8 * g + 5]); o.w = cvtpk(v[8 * g + 6], v[8 * g + 7]);
            *(u32x4*)(dst + (size_t)n * K + kb * 64 + 32 * half + 8 * g) = o; }
    }
}

template <int MODE, bool DUMMY = false> DEV void norm_phase(Frame& F, const float* gy, int wpg = 8) {
    if (F.wave >= wpg) return;
    const int gw = F.bid * wpg + F.wave, NW = F.G * wpg;
    u32x4 yq[4], hq[4];
    if (MODE != 0 && gw < kM) {
#pragma unroll
        for (int j = 0; j < 4; ++j) { yq[j] = __builtin_nontemporal_load((const u32x4*)(F.Y() + (size_t)gw * kD + 8 * (F.lane + 64 * j))); hq[j] = *(const u32x4*)(F.HB() + (size_t)gw * kD + 8 * (F.lane + 64 * j)); }
    }
    for (int m = gw; m < kM; m += NW) {
        float h[32];
        u16* hb = F.HB() + (size_t)m * kD;
        if (MODE == 0) {
            const float* xrow = F.in(I_X) + (size_t)m * kD;
#pragma unroll
            for (int j = 0; j < 4; ++j) { const int e = 8 * (F.lane + 64 * j);
                const f32x4 a = __builtin_nontemporal_load((const f32x4*)(xrow + e)), b = __builtin_nontemporal_load((const f32x4*)(xrow + e + 4));
                h[8 * j + 0] = a.x; h[8 * j + 1] = a.y; h[8 * j + 2] = a.z; h[8 * j + 3] = a.w; h[8 * j + 4] = b.x; h[8 * j + 5] = b.y; h[8 * j + 6] = b.z; h[8 * j + 7] = b.w; }
        } else {
            float y[32]; float ss = 0.f;
#pragma unroll
            for (int j = 0; j < 4; ++j) { unpack8(yq[j], y + 8 * j); unpack8(hq[j], h + 8 * j); }
            if (m + NW < kM) {
#pragma unroll
                for (int j = 0; j < 4; ++j) { yq[j] = __builtin_nontemporal_load((const u32x4*)(F.Y() + (size_t)(m + NW) * kD + 8 * (F.lane + 64 * j))); hq[j] = *(const u32x4*)(F.HB() + (size_t)(m + NW) * kD + 8 * (F.lane + 64 * j)); }
            }
#pragma unroll
            for (int i = 0; i < 32; ++i) ss += y[i] * y[i];
            const float r = 1.0f / sqrtf(sum64(ss) * (1.0f / kD) + kNormEps);
#pragma unroll
            for (int j = 0; j < 4; ++j) { const int e = 8 * (F.lane + 64 * j);
#pragma unroll
                for (int i = 0; i < 8; ++i) h[8 * j + i] += y[8 * j + i] * r * gy[e + i]; }
        }
        if (MODE == 2) {
            float* orow = F.out() + (size_t)m * kD;
#pragma unroll
            for (int j = 0; j < 4; ++j) { const int e = 8 * (F.lane + 64 * j);
                *(f32x4*)(orow + e) = (f32x4){h[8 * j], h[8 * j + 1], h[8 * j + 2], h[8 * j + 3]};
                *(f32x4*)(orow + e + 4) = (f32x4){h[8 * j + 4], h[8 * j + 5], h[8 * j + 6], h[8 * j + 7]}; }
        } else {
            float ss = 0.f;
#pragma unroll
            for (int i = 0; i < 32; ++i) ss += h[i] * h[i];
            const float r2 = 1.0f / sqrtf(sum64(ss) * (1.0f / kD) + kNormEps);
            if (F.lane == 0) F.R2()[m] = r2;
#pragma unroll
            for (int j = 0; j < 4; ++j) *(u32x4*)(hb + 8 * (F.lane + 64 * j)) = pack8(h + 8 * j);
        }
    }
}

constexpr int PL_KX = 0, PL_VX = 16 * 520 * 2, PL_A1 = 2 * 16 * 520 * 2, PL_A2 = PL_A1 + 16 * 72 * 2, PL_A3 = PL_A2 + 16 * 72 * 2, PL_T1 = PL_A3 + 16 * 136 * 2, PL_MU = PL_T1 + 16 * 40 * 2, PL_OT = PL_MU + 1792 * 4, PL_RAW = (PL_OT + 8 * 1536 + 1023) / 1024 * 1024, PL_END = PL_RAW + 65536;
static_assert(PL_RAW % 1024 == 0, "raw tile alignment");
DEV bf16x8 ldsfrag(const LAS u16* base, int stride, int row, int k) { return *(const LAS bf16x8*)(base + row * stride + k); }
DEV bf16x8 glbfrag(const u16* base, int stride, int row, int k) { return *(const bf16x8*)(base + (size_t)row * stride + k); }

DEV void prep_phase(Frame& F, int l) {
    LAS u16* KX = (LAS u16*)(F.lds + PL_KX); LAS u16* VX = (LAS u16*)(F.lds + PL_VX);
    LAS u16* A1 = (LAS u16*)(F.lds + PL_A1); LAS u16* A2 = (LAS u16*)(F.lds + PL_A2); LAS u16* A3 = (LAS u16*)(F.lds + PL_A3); LAS u16* T1 = (LAS u16*)(F.lds + PL_T1);
    LAS float* MU = (LAS float*)(F.lds + PL_MU); LAS float* PT = (LAS float*)(F.lds + PL_OT + F.wave * 1536);
    LAS u16* RAW = (LAS u16*)(F.lds + PL_RAW);
    for (int i = F.tid; i < 1792; i += 512) MU[i] = F.in(I_MU)[(size_t)l * 1792 + i];
    { const int ch = 64 * F.wave + F.lane; PT[F.lane] = F.in(I_W0)[l * 512 + ch]; PT[64 + F.lane] = F.in(I_A0)[l * 512 + ch]; PT[128 + F.lane] = F.in(I_KK)[l * 512 + ch]; PT[192 + F.lane] = F.in(I_KA)[l * 512 + ch];
      PT[256 + F.lane] = l > 0 ? F.in(I_V0)[(l - 1) * 512 + ch] : 0.f; }
    __syncthreads();
    const u16* sw = F.SW() + (size_t)l * SW_LAYER;
    const int w = F.wave, c = F.lane & 15, q = F.lane >> 4;
    bf16x8 wfr[4][2], afr[4][2];
#pragma unroll
    for (int tn = 0; tn < 4; ++tn)
#pragma unroll
        for (int ks = 0; ks < 2; ++ks) { wfr[tn][ks] = glbfrag(sw + SW_WUP, 64, 64 * w + 16 * tn + c, 32 * ks + 8 * q); afr[tn][ks] = glbfrag(sw + SW_AUP, 64, 64 * w + 16 * tn + c, 32 * ks + 8 * q); }
#define PREP_DMA(it_) do { const int tk_ = (it_) * 16; const bool first_ = (tk_ % kS) == 0; _Pragma("unroll") for (int j_ = 0; j_ < 8; ++j_) { int p_ = 512 * w + 64 * j_ + F.lane; if (p_ >= 17 * 224) p_ = 0; \
        const int r_ = p_ / 224, g_ = p_ % 224; const int tok_ = tk_ - 1 + r_ + ((first_ && r_ == 0) ? 1 : 0); \
        glds16(F.P() + (size_t)tok_ * kNP + PC_RW + 8 * g_, RAW + (512 * w + 64 * j_) * 8, F.lane); } } while (0)
    int it0 = F.bid, itS = F.G, itE = kM / 16;
    if (F.G == 2 * kB * kH) { constexpr int NSC = kB * kH, SPLIT = 9 * NSC;
        if (F.bid < NSC) { it0 = F.bid; itE = SPLIT; } else { it0 = SPLIT + (F.bid - NSC); } itS = NSC; }
    if (it0 < itE) PREP_DMA(it0);
    for (int item = it0; item < itE; item += itS) {
        const int tk0 = item * 16;
        wait_vm0(); __syncthreads();
#define PREP_MIX(row_, col_) float xs[8]; { float cur[8], prv[8]; const u32x4 cq = *(const LAS u32x4*)(RAW + ((row_) + 1) * 1792 + (col_)); u32x4 pq = *(const LAS u32x4*)(RAW + (row_) * 1792 + (col_)); \
            if (((tk0 + (row_)) % kS) == 0) pq = (u32x4){0u, 0u, 0u, 0u}; \
            unpack8(cq, cur); unpack8(pq, prv); const f32x4 m0 = *(const LAS f32x4*)(MU + (col_)), m1 = *(const LAS f32x4*)(MU + (col_) + 4); \
            xs[0] = cur[0] + (prv[0] - cur[0]) * m0.x; xs[1] = cur[1] + (prv[1] - cur[1]) * m0.y; xs[2] = cur[2] + (prv[2] - cur[2]) * m0.z; xs[3] = cur[3] + (prv[3] - cur[3]) * m0.w; \
            xs[4] = cur[4] + (prv[4] - cur[4]) * m1.x; xs[5] = cur[5] + (prv[5] - cur[5]) * m1.y; xs[6] = cur[6] + (prv[6] - cur[6]) * m1.z; xs[7] = cur[7] + (prv[7] - cur[7]) * m1.w; }
#pragma unroll 1
        for (int i = 0; i < 6; ++i) { const int idx = F.tid + 512 * i; const int row = idx / 192, col = 8 * (idx % 192);
            PREP_MIX(row, col);
            if (col < 512) { *(u32x4*)(F.RWS() + (size_t)(tk0 + row) * kRWS + RS_R + col) = pack8(xs); }
            else if (col < 1024) { *(LAS u32x4*)(KX + row * 520 + (col - 512)) = pack8(xs); }
            else { *(LAS u32x4*)(VX + row * 520 + (col - 1024)) = pack8(xs); } }
        int lt_ = F.tid;
#ifndef HOST_EMU
        asm volatile("" : "+v"(lt_));
#endif
        if (w < 2) { const int p = lt_, row = p >> 3, cg = 8 * (p & 7);
            PREP_MIX(row, 1536 + cg);
#pragma unroll
            for (int e = 0; e < 8; ++e) { const float t = fexp(2.0f * xs[e]); xs[e] = 1.0f - 2.0f * frcp(t + 1.0f); }
            *(LAS u32x4*)(A1 + row * 72 + cg) = pack8(xs); }
        else if (w < 4) { const int p = lt_ - 128, row = p >> 3, cg = 8 * (p & 7);
            PREP_MIX(row, 1600 + cg);
            *(LAS u32x4*)(A2 + row * 72 + cg) = pack8(xs); }
        else { const int p = lt_ - 256, row = p >> 4, cg = 8 * (p & 15);
            PREP_MIX(row, 1664 + cg);
#pragma unroll
            for (int e = 0; e < 8; ++e) xs[e] = fsig(xs[e]);
            *(LAS u32x4*)(A3 + row * 136 + cg) = pack8(xs); }
#undef PREP_MIX
        __syncthreads();
        if (item + itS < itE) PREP_DMA(item + itS);
        bf16x8 gfr[4][4];
#pragma unroll
        for (int tn = 0; tn < 4; ++tn) {
#pragma unroll
            for (int ks = 0; ks < 4; ++ks) gfr[tn][ks] = glbfrag(sw + SW_GUP, 128, 64 * w + 16 * tn + c, 32 * ks + 8 * q); }
        if (l > 0) {
            if (w < 2) { const int tn = w; f32x4 acc = {0.f, 0.f, 0.f, 0.f}; bf16x8 dn[16];
#pragma unroll
                for (int ks = 0; ks < 16; ++ks) dn[ks] = glbfrag(sw + SW_VDN, 512, 16 * tn + c, 32 * ks + 8 * q);
#pragma unroll
                for (int ks = 0; ks < 16; ++ks) acc = mfma16(ldsfrag(VX, 520, c, 32 * ks + 8 * q), dn[ks], acc);
#pragma unroll
                for (int j = 0; j < 4; ++j) T1[(4 * q + j) * 40 + 16 * tn + c] = f2bf(acc[j]); }
            __syncthreads();
        }
        {
            const int trow = c;
            int pto = 4 * q;
#ifndef HOST_EMU
            asm volatile("" : "+v"(pto));
#endif
            const LAS float* PTq = PT + pto;
            u16* orow = F.RWS() + (size_t)(tk0 + trow) * kRWS + 64 * w + 4 * q;
#pragma unroll
            for (int tn = 0; tn < 4; ++tn) { f32x4 acc = {0.f, 0.f, 0.f, 0.f};
#pragma unroll
                for (int ks = 0; ks < 4; ++ks) acc = mfma16(gfr[tn][ks], ldsfrag(A3, 136, trow, 32 * ks + 8 * q), acc);
                u32x2 o; o.x = cvtpk(acc[0], acc[1]); o.y = cvtpk(acc[2], acc[3]);
                *(u32x2*)(orow + RS_G + 16 * tn) = o; }
            bf16x8 vfr[4]; u32x2 vfq[4];
#pragma unroll
            for (int tn = 0; tn < 4; ++tn) vfr[tn] = glbfrag(sw + SW_VUP, 32, 64 * w + 16 * tn + c, 8 * q);
            if (l > 0) {
#pragma unroll
                for (int tn = 0; tn < 4; ++tn) vfq[tn] = *(const u32x2*)(F.VF() + (size_t)(tk0 + trow) * kG + 64 * w + 16 * tn + 4 * q); }
            const bf16x8 x10 = ldsfrag(A1, 72, trow, 8 * q), x11 = ldsfrag(A1, 72, trow, 32 + 8 * q), x20 = ldsfrag(A2, 72, trow, 8 * q), x21 = ldsfrag(A2, 72, trow, 32 + 8 * q);
#pragma unroll
            for (int tn = 0; tn < 4; ++tn) { f32x4 acc = {0.f, 0.f, 0.f, 0.f};
                acc = mfma16(wfr[tn][0], x10, acc); acc = mfma16(wfr[tn][1], x11, acc);
                const f32x4 w0v = *(const LAS f32x4*)(PTq + 16 * tn);
                u32x2 o; o.x = cvtpk(fexp(-kDecayScale * fsig(w0v.x + acc[0])), fexp(-kDecayScale * fsig(w0v.y + acc[1]))); o.y = cvtpk(fexp(-kDecayScale * fsig(w0v.z + acc[2])), fexp(-kDecayScale * fsig(w0v.w + acc[3])));
                *(u32x2*)(orow + RS_W + 16 * tn) = o; }
            f32x4 av[4]; float ss = 0.f;
#pragma unroll
            for (int tn = 0; tn < 4; ++tn) { f32x4 acc = {0.f, 0.f, 0.f, 0.f};
                acc = mfma16(afr[tn][0], x20, acc); acc = mfma16(afr[tn][1], x21, acc);
                const f32x4 a0v = *(const LAS f32x4*)(PTq + 64 + 16 * tn), kkv = *(const LAS f32x4*)(PTq + 128 + 16 * tn);
                const u32x2 kb = *(const LAS u32x2*)(KX + trow * 520 + 64 * w + 16 * tn + 4 * q);
                const f32x4 kf = {bf2f((u16)(kb.x & 0xffffu)), bf2f((u16)(kb.x >> 16)), bf2f((u16)(kb.y & 0xffffu)), bf2f((u16)(kb.y >> 16))};
                av[tn] = (f32x4){fsig(a0v.x + acc[0]), fsig(a0v.y + acc[1]), fsig(a0v.z + acc[2]), fsig(a0v.w + acc[3])};
                const f32x4 kr = kf * kkv; ss += (kr.x * kr.x + kr.y * kr.y) + (kr.z * kr.z + kr.w * kr.w); }
            ss += lxany(ss, F.lane, 16); ss += lxany(ss, F.lane, 32);
            const float inv = 1.0f / fmaxf(sqrtf(ss), 1e-12f);
#pragma unroll
            for (int tn = 0; tn < 4; ++tn) {
                const f32x4 kkv = *(const LAS f32x4*)(PTq + 128 + 16 * tn), kav = *(const LAS f32x4*)(PTq + 192 + 16 * tn);
                const u32x2 kb = *(const LAS u32x2*)(KX + trow * 520 + 64 * w + 16 * tn + 4 * q);
                const f32x4 kf = {bf2f((u16)(kb.x & 0xffffu)), bf2f((u16)(kb.x >> 16)), bf2f((u16)(kb.y & 0xffffu)), bf2f((u16)(kb.y >> 16))};
                const f32x4 a = av[tn], kkn = kf * kkv * inv, kp = kf * (1.0f + (a - 1.0f) * kav), bb = a * kkn;
                u32x2 o; o.x = cvtpk(kp.x, kp.y); o.y = cvtpk(kp.z, kp.w); *(u32x2*)(orow + RS_K + 16 * tn) = o;
                o.x = cvtpk(kkn.x, kkn.y); o.y = cvtpk(kkn.z, kkn.w); *(u32x2*)(orow + RS_KK + 16 * tn) = o;
                o.x = cvtpk(bb.x, bb.y); o.y = cvtpk(bb.z, bb.w); *(u32x2*)(orow + RS_B + 16 * tn) = o; }
            const bf16x8 t1f = ldsfrag(T1, 40, trow, 8 * q);
#pragma unroll
            for (int tn = 0; tn < 4; ++tn) {
                f32x4 acc = {0.f, 0.f, 0.f, 0.f};
                if (l > 0) acc = mfma16(vfr[tn], t1f, acc);
                const u32x2 vb = *(const LAS u32x2*)(VX + trow * 520 + 64 * w + 16 * tn + 4 * q);
                f32x4 vo = {bf2f((u16)(vb.x & 0xffffu)), bf2f((u16)(vb.x >> 16)), bf2f((u16)(vb.y & 0xffffu)), bf2f((u16)(vb.y >> 16))};
                if (l > 0) { const f32x4 v0v = *(const LAS f32x4*)(PTq + 256 + 16 * tn);
                    const f32x4 v1 = {bf2f((u16)(vfq[tn].x & 0xffffu)), bf2f((u16)(vfq[tn].x >> 16)), bf2f((u16)(vfq[tn].y & 0xffffu)), bf2f((u16)(vfq[tn].y >> 16))};
                    const f32x4 mix = {fsig(v0v.x + acc[0]), fsig(v0v.y + acc[1]), fsig(v0v.z + acc[2]), fsig(v0v.w + acc[3])};
                    vo = vo + (v1 - vo) * mix; }
                else *(u32x2*)(F.VF() + (size_t)(tk0 + trow) * kG + 64 * w + 16 * tn + 4 * q) = vb;
                u32x2 o; o.x = cvtpk(vo.x, vo.y); o.y = cvtpk(vo.z, vo.w); *(u32x2*)(orow + RS_V + 16 * tn) = o; }
        }
    }
#undef PREP_DMA
}

#ifndef RWKV_SCAN_MFMA
#define RWKV_SCAN_MFMA 1
#endif
constexpr int SL_TB = 32, SL_TS = SL_TB * 64;
constexpr int SL_BUF = 7 * SL_TS * 4;
constexpr int SL_Y = 2 * SL_BUF, SL_U = SL_Y + 2 * SL_TS * 4, SL_END = SL_U + 2 * (SL_TB / 2) * 256 * 2;
DEV float dot4(f32x4 a, f32x4 b) { return (a.x * b.x + a.y * b.y) + (a.z * b.z + a.w * b.w); }
DEV void rwkv_scan(Frame& F, int l, int b, int hh) {
    constexpr int TB = SL_TB, TS = SL_TS, NB = kS / TB;
    int tid_ = F.tid;
#ifndef HOST_EMU
    asm volatile("" : "+v"(tid_));
#endif
    const int xtid = tid_, xlane = tid_ & 63;
    const int mq = xlane >> 4, mi0 = 16 * (F.wave & 3) + (xlane & 15);
    f32x4 SA0 = {0.f, 0.f, 0.f, 0.f}, SA1 = SA0, SB0 = SA0, SB1 = SA0; bf16x8 sA = {0, 0, 0, 0, 0, 0, 0, 0}, sB = sA;
    const int es = xtid & 15, ech = 64 * hh + 4 * es;
    const f32x4 lnw = *(const f32x4*)(F.in(I_LNW) + l * 512 + ech), lnb = *(const f32x4*)(F.in(I_LNB) + l * 512 + ech), rk = *(const f32x4*)(F.in(I_RK) + l * 512 + ech);
    const u16* rws = F.RWS() + (size_t)b * kS * kRWS + 64 * hh;
    const int hid = xtid - 256, hp = (hid >> 3) & 15, hg = hid & 7;
    u32x4 pre[14];
    const unsigned hoffb = (unsigned)((2 * hp) * kRWS + 8 * hg) * 2u;
#define RW_LOAD(blk_) do { const char* rb_ = (const char*)(rws + (size_t)(blk_) * TB * kRWS); _Pragma("unroll") for (int rr_ = 0; rr_ < 2; ++rr_) _Pragma("unroll") for (int tz_ = 0; tz_ < 7; ++tz_) \
        pre[7 * rr_ + tz_] = __builtin_nontemporal_load((const u32x4*)(rb_ + hoffb + (unsigned)((rr_ * kRWS + tz_ * 512) * 2))); } while (0)
#define PUT8(slot_, row_, v_) do { LAS float* d_ = LTn + (slot_) * TS + (row_) * 64 + 8 * hg; *(LAS f32x4*)d_ = (f32x4){(v_)[0], (v_)[1], (v_)[2], (v_)[3]}; *(LAS f32x4*)(d_ + 4) = (f32x4){(v_)[4], (v_)[5], (v_)[6], (v_)[7]}; } while (0)
#define PUTU(row_, v_) do { u32x4 o_; o_.x = cvtpk((v_)[0], (v_)[1]); o_.y = cvtpk((v_)[2], (v_)[3]); o_.z = cvtpk((v_)[4], (v_)[5]); o_.w = cvtpk((v_)[6], (v_)[7]); *(LAS u32x4*)(Un + hp * 256 + (row_) * 64 + 8 * hg) = o_; } while (0)
#define DOT8(a_, b_) ((((a_)[0] * (b_)[0] + (a_)[1] * (b_)[1]) + ((a_)[2] * (b_)[2] + (a_)[3] * (b_)[3])) + (((a_)[4] * (b_)[4] + (a_)[5] * (b_)[5]) + ((a_)[6] * (b_)[6] + (a_)[7] * (b_)[7])))
#define RW_STAGE(bi_) do { LAS float* LTn = (LAS float*)(F.lds + (bi_) * SL_BUF); LAS u16* Un = (LAS u16*)(F.lds + SL_U + (bi_) * (TB / 2) * 512); \
        float r1[8], w1[8], k1[8], x1[8], kk1[8], b1[8], r2[8], w2[8], k2[8], kk2[8], b2[8], t_[8], u_[8]; \
        unpack8(pre[0], r1); unpack8(pre[1], w1); unpack8(pre[2], k1); unpack8(pre[4], kk1); unpack8(pre[5], b1); \
        unpack8(pre[7], r2); unpack8(pre[8], w2); unpack8(pre[9], k2); unpack8(pre[11], kk2); unpack8(pre[12], b2); \
        PUT8(0, 2 * hp, r1); PUT8(0, 2 * hp + 1, r2); PUT8(2, 2 * hp, k1); PUT8(2, 2 * hp + 1, k2); PUT8(5, 2 * hp + 1, b2); \
        unpack8(pre[3], x1); PUT8(3, 2 * hp, x1); unpack8(pre[10], x1); PUT8(3, 2 * hp + 1, x1); unpack8(pre[6], x1); PUT8(6, 2 * hp, x1); unpack8(pre[13], x1); PUT8(6, 2 * hp + 1, x1); \
        PUTU(0, kk1); \
        const float c0 = sum8(DOT8(k1, kk2)), c1 = sum8(DOT8(b1, kk2)), c2 = sum8(DOT8(k1, r1)), c3 = sum8(DOT8(b1, r1)), c6 = sum8(DOT8(k2, r2)), c7 = sum8(DOT8(b2, r2)); \
        _Pragma("unroll") for (int e_ = 0; e_ < 8; ++e_) t_[e_] = w1[e_] * kk2[e_]; PUTU(1, t_); \
        _Pragma("unroll") for (int e_ = 0; e_ < 8; ++e_) t_[e_] = w1[e_] * r1[e_]; PUTU(2, t_); \
        _Pragma("unroll") for (int e_ = 0; e_ < 8; ++e_) u_[e_] = w1[e_] * w2[e_]; PUT8(1, 2 * hp, u_); \
        _Pragma("unroll") for (int e_ = 0; e_ < 8; ++e_) t_[e_] = u_[e_] * r2[e_]; PUTU(3, t_); \
        _Pragma("unroll") for (int e_ = 0; e_ < 8; ++e_) t_[e_] = k1[e_] * w2[e_]; PUT8(1, 2 * hp + 1, t_); const float c4 = sum8(DOT8(t_, r2)); \
        _Pragma("unroll") for (int e_ = 0; e_ < 8; ++e_) t_[e_] = b1[e_] * w2[e_]; PUT8(5, 2 * hp, t_); const float c5 = sum8(DOT8(t_, r2)); \
        if (hg == 0) { LAS float* d_ = LTn + 4 * TS + (2 * hp) * 64; *(LAS f32x4*)d_ = (f32x4){c0, c1, c2, c3}; *(LAS f32x4*)(d_ + 4) = (f32x4){c4, c5, c6, c7}; } } while (0)
    const bool helper = F.wave == 4 || F.wave == 5;
    if (helper) { RW_LOAD(0); RW_STAGE(0); if (NB > 1) RW_LOAD(1); }
    lds_sync();
    for (int blk = 0; blk < NB; ++blk) {
        const int bi = blk & 1; const size_t tok0 = (size_t)b * kS + (size_t)blk * TB;
        LAS float* LT = (LAS float*)(F.lds + bi * SL_BUF); LAS float* LY = (LAS float*)(F.lds + SL_Y + bi * TS * 4); LAS u16* LU = (LAS u16*)(F.lds + SL_U + bi * (TB / 2) * 512);
        if (F.wave < 4) {
#pragma unroll 2
        for (int pi = 0; pi < TB / 2; ++pi) {
            const f32x4 z4 = {0.f, 0.f, 0.f, 0.f};
            const LAS u16* uf = LU + pi * 256 + (xlane & 3) * 64 + 8 * mq;
            f32x4 acc = mfma16(*(const LAS bf16x8*)uf, sA, z4);
            acc = mfma16(*(const LAS bf16x8*)(uf + 32), sB, acc);
            const LAS float* base = LT + (2 * pi) * 64 + 8 * mq;
            const f32x4 wa0 = *(const LAS f32x4*)(base + TS), wa1 = *(const LAS f32x4*)(base + TS + 4), wb0 = *(const LAS f32x4*)(base + TS + 32), wb1 = *(const LAS f32x4*)(base + TS + 36);
            const f32x4 ka0 = *(const LAS f32x4*)(base + TS + 64), ka1 = *(const LAS f32x4*)(base + TS + 68), kb0 = *(const LAS f32x4*)(base + TS + 96), kb1 = *(const LAS f32x4*)(base + TS + 100);
            const f32x4 ba0 = *(const LAS f32x4*)(base + 5 * TS), ba1 = *(const LAS f32x4*)(base + 5 * TS + 4), bb0 = *(const LAS f32x4*)(base + 5 * TS + 32), bb1 = *(const LAS f32x4*)(base + 5 * TS + 36);
            const f32x4 kc0 = *(const LAS f32x4*)(base + 2 * TS + 64), kc1 = *(const LAS f32x4*)(base + 2 * TS + 68), kd0 = *(const LAS f32x4*)(base + 2 * TS + 96), kd1 = *(const LAS f32x4*)(base + 2 * TS + 100);
            const f32x4 bc0 = *(const LAS f32x4*)(base + 5 * TS + 64), bc1 = *(const LAS f32x4*)(base + 5 * TS + 68), bd0 = *(const LAS f32x4*)(base + 5 * TS + 96), bd1 = *(const LAS f32x4*)(base + 5 * TS + 100);
            const f32x4 s0 = *(const LAS f32x4*)(LT + 4 * TS + (2 * pi) * 64), s1 = *(const LAS f32x4*)(LT + 4 * TS + (2 * pi) * 64 + 4);
            const float v1 = LT[3 * TS + (2 * pi) * 64 + mi0], v2 = LT[3 * TS + (2 * pi + 1) * 64 + mi0];
            const float p1 = acc[0];
            const float p2 = (acc[1] + v1 * s0[0]) - p1 * s0[1];
            const float y1 = (acc[2] + v1 * s0[2]) - p1 * s0[3];
            const float y2 = ((acc[3] + v1 * s1[0]) - p1 * s1[1]) + (v2 * s1[2] - p2 * s1[3]);
            SA0 = ((SA0 * wa0 + ka0 * v1) - ba0 * p1) + (kc0 * v2 - bc0 * p2); SA1 = ((SA1 * wa1 + ka1 * v1) - ba1 * p1) + (kc1 * v2 - bc1 * p2);
            SB0 = ((SB0 * wb0 + kb0 * v1) - bb0 * p1) + (kd0 * v2 - bd0 * p2); SB1 = ((SB1 * wb1 + kb1 * v1) - bb1 * p1) + (kd1 * v2 - bd1 * p2);
            { u32x4 pk; pk.x = cvtpk(SA0.x, SA0.y); pk.y = cvtpk(SA0.z, SA0.w); pk.z = cvtpk(SA1.x, SA1.y); pk.w = cvtpk(SA1.z, SA1.w); sA = __builtin_bit_cast(bf16x8, pk); }
            { u32x4 pk; pk.x = cvtpk(SB0.x, SB0.y); pk.y = cvtpk(SB0.z, SB0.w); pk.z = cvtpk(SB1.x, SB1.y); pk.w = cvtpk(SB1.z, SB1.w); sB = __builtin_bit_cast(bf16x8, pk); }
            if (mq == 0) { LY[(2 * pi) * 64 + mi0] = y1; LY[(2 * pi + 1) * 64 + mi0] = y2; }
        }
        } else if (helper && blk + 1 < NB) { RW_STAGE(bi ^ 1); if (blk + 2 < NB) RW_LOAD(blk + 2); }
        lds_sync();
        {
            const int et = xtid >> 4;
            const f32x4 y = *(const LAS f32x4*)(LY + et * 64 + 4 * es);
            const f32x4 r = *(const LAS f32x4*)(LT + et * 64 + 4 * es), k = *(const LAS f32x4*)(LT + 2 * TS + et * 64 + 4 * es), v = *(const LAS f32x4*)(LT + 3 * TS + et * 64 + 4 * es);
            const f32x4 g = *(const LAS f32x4*)(LT + 6 * TS + et * 64 + 4 * es);
            const float mean = sum16(y.x + y.y + y.z + y.w) * (1.0f / 64.0f);
            const f32x4 d = y - mean;
            const float var = sum16(d.x * d.x + d.y * d.y + d.z * d.z + d.w * d.w) * (1.0f / 64.0f);
            const float rstd = frsq(var + kRwkvLnEps);
            const float bonus = sum16(r.x * k.x * rk.x + r.y * k.y * rk.y + r.z * k.z * rk.z + r.w * k.w * rk.w);
            u32x2 o;
            o.x = cvtpk((d.x * rstd * lnw.x + lnb.x + bonus * v.x) * g.x, (d.y * rstd * lnw.y + lnb.y + bonus * v.y) * g.y);
            o.y = cvtpk((d.z * rstd * lnw.z + lnb.z + bonus * v.z) * g.z, (d.w * rstd * lnw.w + lnb.w + bonus * v.w) * g.w);
            *(u32x2*)(F.O() + (tok0 + et) * kD + 1536 + ech) = o;
        }
        lds_sync();
    }
#undef RW_LOAD
#undef RW_STAGE
#undef PUT8
#undef PUTU
#undef DOT8
}

constexpr int CQ = 72, CT = 40;
constexpr int CL_QP = 0, CL_KP = 32 * CQ, CL_KT = 2 * 32 * CQ, CL_VT = CL_KT + 64 * CT, CL_PM = CL_VT + 80 * CT, CL_ST = CL_PM + 32 * CT, CL_E16 = CL_ST + 80 * CQ;
constexpr int CL_DEC = CL_E16 * 2;
constexpr int CL_RAW = CL_DEC + 256;
constexpr int CL_BYTES = CL_RAW + 16384;
static_assert(CL_RAW % 1024 == 0 || true, "raw");

template <int KIND> DEV void chain_abc(Frame& F, LAS unsigned char* wl, int l, int b, int hh) {
    constexpr int NTE = KIND == 2 ? 5 : 4;
    constexpr int NCH = kS / 32;
    LAS u16* QP = (LAS u16*)wl + CL_QP; LAS u16* KP = (LAS u16*)wl + CL_KP; LAS u16* KT = (LAS u16*)wl + CL_KT; LAS u16* VT = (LAS u16*)wl + CL_VT;
    LAS u16* PM = (LAS u16*)wl + CL_PM; LAS u16* ST = (LAS u16*)wl + CL_ST; LAS float* DEC = (LAS float*)(wl + CL_DEC); LAS u16* RAW = (LAS u16*)(wl + CL_RAW);
    int lane_ = F.lane;
#ifndef HOST_EMU
    asm volatile("" : "+v"(lane_));
#endif
    const int lane = lane_, d = lane, c = lane & 15, q = lane >> 4;
    const int pbase = KIND == 0 ? PC_RET : KIND == 1 ? PC_HG : PC_ML;
    const int obase = 512 * KIND + 64 * hh;
    const u16* pchain = F.P() + (size_t)b * kS * kNP + pbase + 64 * hh;
    float gam = 1.f, igam = 1.f, g32 = 1.f, cdl = 1.f, sdl = 0.f, tc_n = 1.f, ts_n = 0.f;
    float lb = 0.f;
    float cwq[4] = {0, 0, 0, 0}, cwk[4] = {0, 0, 0, 0}, cbq = 0.f, cbk = 0.f, ibias = 0.f, fbias = 0.f;
    float qh1 = 0.f, qh2 = 0.f, qh3 = 0.f, kh1 = 0.f, kh2 = 0.f, kh3 = 0.f;
    float nw[4] = {1.f, 1.f, 1.f, 1.f};
    float gi_n = 0.f, gf_n = 0.f;
    if (KIND == 0) { const float lg = log1pf(-exp2f(-5.0f - (float)hh)); gam = expf(lg); igam = expf(-lg); g32 = expf(32.0f * lg);
        const float* tr = F.TRIG() + 2 * (d & 31); tc_n = tr[0]; ts_n = tr[1]; cdl = tr[64]; sdl = tr[65]; }
    if (KIND == 1) {
        const float* lg4 = F.in(I_HLB) + 64 * hh + d; float e[4], mx = -1e30f, sm = 0.f;
#pragma unroll
        for (int i = 0; i < 4; ++i) { e[i] = lg4[i * 512]; mx = fmaxf(mx, e[i]); }
#pragma unroll
        for (int i = 0; i < 4; ++i) { e[i] = expf(e[i] - mx); sm += e[i]; }
#pragma unroll
        for (int i = 1; i < 4; ++i) if (i <= l) lb += e[i] / sm;
#pragma unroll
        for (int tn = 0; tn < 4; ++tn) nw[tn] = F.in(I_HNW)[l * 512 + 64 * hh + 16 * tn + c];
    }
    if (KIND == 2) {
        const float* cw = F.in(I_MCW) + (size_t)l * 4 * 1024;
#pragma unroll
        for (int j = 0; j < 4; ++j) { cwq[j] = cw[j * 1024 + 64 * hh + d]; cwk[j] = cw[j * 1024 + 512 + 64 * hh + d]; }
        cbq = F.in(I_MCB)[l * 1024 + 64 * hh + d]; cbk = F.in(I_MCB)[l * 1024 + 512 + 64 * hh + d];
        ibias = F.in(I_MIB)[l * 8 + hh]; fbias = F.in(I_MFB)[l * 8 + hh];
#pragma unroll
        for (int tn = 0; tn < 4; ++tn) nw[tn] = F.in(I_MNW)[l * 512 + 64 * hh + 16 * tn + c];
        for (int i = lane; i < 16 * CT; i += 64) VT[64 * CT + i] = (i < CT) ? (u16)0x3F80 : (u16)0;
    }
    for (int i = lane; i < 80 * CQ; i += 64) ST[i] = 0;
    f32x4 accS[4][NTE];
#pragma unroll
    for (int dm = 0; dm < 4; ++dm)
#pragma unroll
        for (int te = 0; te < NTE; ++te) accS[dm][te] = (f32x4){0.f, 0.f, 0.f, 0.f};
    const unsigned dma_off = (unsigned)((lane >> 3) * kNP + 8 * (lane & 7));
    const unsigned gate_off = (unsigned)(lane * kNP + hh);
    const unsigned st_off = (unsigned)((lane >> 3) * kD + 8 * (lane & 7));
    const u16* pgate = F.P() + (size_t)b * kS * kNP + PC_MLG;
    u16* uchain = F.O() + (size_t)b * kS * kD + obase;
#define CH_DMA(ch_) do { const u16* g_ = pchain + (size_t)(ch_) * 32 * kNP; \
        _Pragma("unroll") for (int T_ = 0; T_ < 4; ++T_) _Pragma("unroll") for (int rb_ = 0; rb_ < 4; ++rb_) glds16(g_ + (512 * T_ + 8 * rb_ * kNP) + dma_off, RAW + T_ * 2048 + rb_ * 512, lane); } while (0)
#define CH_DMA_RB(ch_, rb_) do { const u16* g_ = pchain + (size_t)(ch_) * 32 * kNP; \
        _Pragma("unroll") for (int T_ = 0; T_ < 4; ++T_) glds16(g_ + (512 * T_ + 8 * (rb_) * kNP) + dma_off, RAW + T_ * 2048 + (rb_) * 512, lane); } while (0)
#define CH_NEXT_RB(r_) do { if ((((r_) + 2) & 7) == 0 && ch + 1 < NCH) { asm volatile("s_waitcnt lgkmcnt(0)" ::: "memory"); CH_DMA_RB(ch + 1, (r_) >> 3); } } while (0)
    CH_DMA(0);
    if (KIND == 2 && lane < 32) { const u16* grow = pgate + gate_off; gi_n = bf2f(grow[0]); gf_n = bf2f(grow[8]); }
    wave_sync();

#pragma unroll 1
    for (int ch = 0; ch < NCH; ++ch) {
        const int t0 = ch * 32; const size_t tok0 = (size_t)b * kS + t0;
        float adec = 1.f;
        wait_vm0(); wave_sync();
        unsigned gpk[2][4][2];
#pragma unroll
        for (int tm = 0; tm < 2; ++tm)
#pragma unroll
            for (int j = 0; j < 4; ++j) { const LAS u16* gr = RAW + 3 * 2048 + (16 * tm + 4 * q + j) * 64 + c;
                gpk[tm][j][0] = (unsigned)gr[0] | ((unsigned)gr[16] << 16); gpk[tm][j][1] = (unsigned)gr[32] | ((unsigned)gr[48] << 16); }
        const float gi_c = gi_n, gf_c = gf_n;
        const int swz = (d >> 3) & 3;
#define KTV_IDX(r_) (d * CT + 8 * (((r_) >> 3) ^ swz) + ((r_) & 7))
        if (KIND == 0) {
            float qd = gam, kd = igam;
            float cs = tc_n, sn = ts_n;
#pragma unroll 2
            for (int r = 0; r < 32; r += 2) {
                float qx[2], kx[2]; u16 vb[2];
#pragma unroll
                for (int u = 0; u < 2; ++u) {
                    const float qv = bf2f(RAW[(r + u) * 64 + d]), kv = bf2f(RAW[2048 + (r + u) * 64 + d]); vb[u] = RAW[4096 + (r + u) * 64 + d];
                    const float qo = xswap32(qv, d < 32), ko = xswap32(kv, d < 32);
                    const float qr = d < 32 ? qv * cs - qo * sn : qo * sn + qv * cs;
                    const float kr = (d < 32 ? kv * cs - ko * sn : ko * sn + kv * cs) * 0.125f;
                    qx[u] = qr * qd; kx[u] = kr * kd; qd *= gam; kd *= igam;
                    { const float c2 = cs * cdl - sn * sdl; sn = sn * cdl + cs * sdl; cs = c2; }
                }
                const unsigned qp = cvtpk(qx[0], qx[1]), kp = cvtpk(kx[0], kx[1]);
                QP[r * CQ + d] = (u16)(qp & 0xffffu); QP[(r + 1) * CQ + d] = (u16)(qp >> 16); KP[r * CQ + d] = (u16)(kp & 0xffffu); KP[(r + 1) * CQ + d] = (u16)(kp >> 16);
                *(LAS unsigned*)(KT + KTV_IDX(r)) = kp; *(LAS unsigned*)(VT + KTV_IDX(r)) = (unsigned)vb[0] | ((unsigned)vb[1] << 16);
                CH_NEXT_RB(r);
            }
            adec = g32;
        } else if (KIND == 1) {
            float E = 1.f;
#pragma unroll 2
            for (int r = 0; r < 32; r += 2) {
                float qx[2], kx[2]; u16 vb[2];
#pragma unroll
                for (int u = 0; u < 2; ++u) {
                    const float qv = bf2f(RAW[(r + u) * 64 + d]), fv = bf2f(RAW[2048 + (r + u) * 64 + d]); vb[u] = RAW[4096 + (r + u) * 64 + d];
                    const float ft = lb + (1.0f - lb) * fsig(fv);
                    E = fmaxf(E * ft, 1e-30f);
                    qx[u] = qv * fsig(qv) * 0.125f * E; kx[u] = (1.0f - ft) * frcp(E);
                }
                const unsigned qp = cvtpk(qx[0], qx[1]), kp = cvtpk(kx[0], kx[1]);
                QP[r * CQ + d] = (u16)(qp & 0xffffu); QP[(r + 1) * CQ + d] = (u16)(qp >> 16); KP[r * CQ + d] = (u16)(kp & 0xffffu); KP[(r + 1) * CQ + d] = (u16)(kp >> 16);
                *(LAS unsigned*)(KT + KTV_IDX(r)) = kp; *(LAS unsigned*)(VT + KTV_IDX(r)) = (unsigned)vb[0] | ((unsigned)vb[1] << 16);
                CH_NEXT_RB(r);
            }
            DEC[d] = E;
        } else {
            const float li = gi_c + ibias, lf = logsig(gf_c + fbias);
            const float Fc = scan32(lf);
            const float eF = fexp(Fc), eK = fexp(li - Fc);
            adec = rdlane(eF, 31);
#pragma unroll
            for (int r = 0; r < 32; r += 2) {
                float qx[2], kx[2]; u16 vb[2];
#pragma unroll
                for (int u = 0; u < 2; ++u) {
                    const float eFr = rdlane(eF, r + u), eKr = rdlane(eK, r + u);
                    const float qv = bf2f(RAW[(r + u) * 64 + d]), kv = bf2f(RAW[2048 + (r + u) * 64 + d]); vb[u] = RAW[4096 + (r + u) * 64 + d];
                    float qc = cbq + cwq[0] * qh3 + cwq[1] * qh2 + cwq[2] * qh1 + cwq[3] * qv;
                    float kc = cbk + cwk[0] * kh3 + cwk[1] * kh2 + cwk[2] * kh1 + cwk[3] * kv;
                    qh3 = qh2; qh2 = qh1; qh1 = qv; kh3 = kh2; kh2 = kh1; kh1 = kv;
                    qx[u] = qc * fsig(qc) * eFr; kx[u] = kc * fsig(kc) * 0.125f * eKr;
                }
                const unsigned qp = cvtpk(qx[0], qx[1]), kp = cvtpk(kx[0], kx[1]);
                QP[r * CQ + d] = (u16)(qp & 0xffffu); QP[(r + 1) * CQ + d] = (u16)(qp >> 16); KP[r * CQ + d] = (u16)(kp & 0xffffu); KP[(r + 1) * CQ + d] = (u16)(kp >> 16);
                *(LAS unsigned*)(KT + KTV_IDX(r)) = kp; *(LAS unsigned*)(VT + KTV_IDX(r)) = (unsigned)vb[0] | ((unsigned)vb[1] << 16);
                CH_NEXT_RB(r);
            }
        }
#undef KTV_IDX
        wave_sync();
        if (ch + 1 < NCH) {
            if (KIND == 2 && lane < 32) { unsigned go_ = gate_off;
#ifndef HOST_EMU
                asm volatile("" : "+v"(go_));
#endif
                const u16* grow = pgate + (size_t)(t0 + 32) * kNP + go_; gi_n = bf2f(grow[0]); gf_n = bf2f(grow[8]); }
            if (KIND == 0) { const float* tr = F.TRIG() + 2 * ((t0 + 32) * 32 + (d & 31)); tc_n = tr[0]; ts_n = tr[1]; }
        }
        bf16x8 qa[2][2];
        {
            bf16x8 kb[2][2];
#pragma unroll
            for (int x = 0; x < 2; ++x)
#pragma unroll
                for (int ks = 0; ks < 2; ++ks) { qa[x][ks] = ldsfrag(QP, CQ, 16 * x + c, 32 * ks + 8 * q); kb[x][ks] = ldsfrag(KP, CQ, 16 * x + c, 32 * ks + 8 * q); }
#pragma unroll
            for (int tm = 0; tm < 2; ++tm)
#pragma unroll
                for (int sn = 0; sn < 2; ++sn) {
                    f32x4 acc = {0.f, 0.f, 0.f, 0.f};
                    if (sn <= tm) {
#pragma unroll
                        for (int ks = 0; ks < 2; ++ks) acc = mfma16(kb[sn][ks], qa[tm][ks], acc);
                    }
                    const int t = 16 * tm + c, sb = 16 * sn + 4 * q;
                    u32x2 pk; pk.x = cvtpk(sb <= t ? acc[0] : 0.f, sb + 1 <= t ? acc[1] : 0.f); pk.y = cvtpk(sb + 2 <= t ? acc[2] : 0.f, sb + 3 <= t ? acc[3] : 0.f);
                    *(LAS u32x2*)(PM + t * CT + sb) = pk;
                }
        }
        wave_sync();
        {
#pragma unroll
            for (int tm = 0; tm < 2; ++tm) {
                const bf16x8 pa = ldsfrag(PM, CT, 16 * tm + c, 8 * q);
                f32x4 out[NTE];
#pragma unroll
                for (int te = 0; te < NTE; ++te) {
                    const int row = 16 * te + c;
                    const bf16x8 vt = ldsfrag(VT, CT, row, 8 * (q ^ ((row >> 3) & 3))), st0 = ldsfrag(ST, CQ, row, 8 * q), st1 = ldsfrag(ST, CQ, row, 32 + 8 * q);
                    f32x4 acc = {0.f, 0.f, 0.f, 0.f};
                    acc = mfma16(pa, vt, acc); acc = mfma16(qa[tm][0], st0, acc); acc = mfma16(qa[tm][1], st1, acc);
                    out[te] = acc;
                }
#pragma unroll
                for (int j = 0; j < 4; ++j) {
                    float v[4];
#pragma unroll
                    for (int te = 0; te < 4; ++te) v[te] = out[te][j];
                    if (KIND == 2) { const float den = sum16(out[NTE - 1][j]);     const float sc = frcp(fmaxf(fabsf(den), 1.0f));
#pragma unroll
                        for (int te = 0; te < 4; ++te) v[te] *= sc; }
                    const float ss = sum16(v[0] * v[0] + v[1] * v[1] + v[2] * v[2] + v[3] * v[3]);
                    const float rs = frsq(ss * (1.0f / 64.0f) + kNormEps);
#pragma unroll
                    for (int te = 0; te < 4; ++te) { const unsigned gw = gpk[tm][j][te >> 1]; const float g = bf2f((u16)((te & 1) ? (gw >> 16) : (gw & 0xffffu)));
                        const float gate = KIND == 0 ? g * fsig(g) : fsig(g);
                        KP[(16 * tm + 4 * q + j) * CQ + 16 * te + c] = (u16)(cvtpk(v[te] * rs * nw[te] * gate, 0.f) & 0xffffu); }
                }
            }
        }
        wave_sync();
#pragma unroll
        for (int i = 0; i < 4; ++i) { const int row = 8 * i + (lane >> 3), cg = lane & 7;
            *(u32x4*)(uchain + (size_t)(t0 + 8 * i) * kD + st_off) = *(const LAS u32x4*)(KP + row * CQ + 8 * cg); }
        {
            bf16x8 vt[NTE], kt[4];
#pragma unroll
            for (int te = 0; te < NTE; ++te) { const int row = 16 * te + c; vt[te] = ldsfrag(VT, CT, row, 8 * (q ^ ((row >> 3) & 3))); }
#pragma unroll
            for (int dm = 0; dm < 4; ++dm) { const int row = 16 * dm + c; kt[dm] = ldsfrag(KT, CT, row, 8 * (q ^ ((row >> 3) & 3))); }
#pragma unroll
            for (int dm = 0; dm < 4; ++dm) {
                f32x4 av;
                if (KIND == 1) av = *(const LAS f32x4*)(DEC + 16 * dm + 4 * q); else av = (f32x4){adec, adec, adec, adec};
#pragma unroll
                for (int te = 0; te < NTE; ++te) {
                    f32x4 acc = mfma16(kt[dm], vt[te], accS[dm][te]);
                    acc = acc * av; accS[dm][te] = acc;
                    u32x2 pk; pk.x = cvtpk(acc[0], acc[1]); pk.y = cvtpk(acc[2], acc[3]);
                    *(LAS u32x2*)(ST + (16 * te + c) * CQ + 16 * dm + 4 * q) = pk;
                }
            }
        }
        wave_sync();
    }
#undef CH_DMA
#undef CH_DMA_RB
#undef CH_NEXT_RB
}

constexpr int RL_RAW = 0;
constexpr int RL_AL = RL_RAW + 7 * 2048, RL_BE = RL_AL + 2304, RL_KA = RL_BE + 2304, RL_RH = RL_KA + 2304, RL_RK = RL_RH + 2304;
constexpr int RL_BET = RL_RK + 2304, RL_KAT = RL_BET + 2048, RL_VT = RL_KAT + 2048, RL_UT = RL_VT + 2048, RL_ZT = RL_UT + 2048;
constexpr int RL_BM = RL_ZT + 2048, RL_CM = RL_BM + 512, RL_DM = RL_CM + 512, RL_TI = RL_DM + 512, RL_AF = RL_TI + 512;
constexpr int RL_SI = RL_AF + 1024, RL_DEC = RL_SI + 64 * 72 * 2, RL_ZERO = RL_DEC + 256, RL_OT = RL_ZERO + 64, RL_END = RL_OT + 2048;
static_assert(RL_END <= CL_BYTES, "rwkv chain lds");
DEV bf16x8 fragT(const LAS u16* base, const LAS u16* zero, int row, int q) { return *(const LAS bf16x8*)(q < 2 ? base + row * 16 + 8 * q : zero); }

DEV void chain_rwkv(Frame& F, LAS unsigned char* wl, int l, int b, int hh) {
    constexpr int NCH = kS / 16;
    LAS u16* RAW = (LAS u16*)(wl + RL_RAW); LAS u16* AL = (LAS u16*)(wl + RL_AL); LAS u16* BE = (LAS u16*)(wl + RL_BE); LAS u16* KA = (LAS u16*)(wl + RL_KA); LAS u16* RH = (LAS u16*)(wl + RL_RH); LAS u16* RK = (LAS u16*)(wl + RL_RK);
    LAS u16* BET = (LAS u16*)(wl + RL_BET); LAS u16* KAT = (LAS u16*)(wl + RL_KAT); LAS u16* VT = (LAS u16*)(wl + RL_VT); LAS u16* UT = (LAS u16*)(wl + RL_UT); LAS u16* ZT = (LAS u16*)(wl + RL_ZT);
    LAS u16* BM = (LAS u16*)(wl + RL_BM); LAS u16* CM = (LAS u16*)(wl + RL_CM); LAS u16* DM = (LAS u16*)(wl + RL_DM); LAS u16* TI = (LAS u16*)(wl + RL_TI); LAS float* AF = (LAS float*)(wl + RL_AF);
    LAS u16* SI = (LAS u16*)(wl + RL_SI); LAS float* DEC = (LAS float*)(wl + RL_DEC); LAS u16* ZERO = (LAS u16*)(wl + RL_ZERO); LAS u16* OT = (LAS u16*)(wl + RL_OT);
    int lane_ = F.lane;
#ifndef HOST_EMU
    asm volatile("" : "+v"(lane_));
#endif
    const int lane = lane_, d = lane, c = lane & 15, q = lane >> 4;
    const float rkd = F.in(I_RK)[l * 512 + 64 * hh + d];
    float lnw[4], lnb[4];
#pragma unroll
    for (int tv = 0; tv < 4; ++tv) { lnw[tv] = F.in(I_LNW)[l * 512 + 64 * hh + 16 * tv + c]; lnb[tv] = F.in(I_LNB)[l * 512 + 64 * hh + 16 * tv + c]; }
    for (int i = lane; i < 64 * 72; i += 64) SI[i] = 0;
    if (lane < 32) ZERO[lane] = 0;
    f32x4 accH[4][4];
#pragma unroll
    for (int tk = 0; tk < 4; ++tk)
#pragma unroll
        for (int tv = 0; tv < 4; ++tv) accH[tk][tv] = (f32x4){0.f, 0.f, 0.f, 0.f};
    const u16* rws = F.RWS() + (size_t)b * kS * kRWS + 64 * hh;
    u16* ochain = F.O() + (size_t)b * kS * kD + 1536 + 64 * hh;
    const unsigned dma_off = (unsigned)((lane >> 3) * kRWS + 8 * (lane & 7));
    const unsigned st_off = (unsigned)((lane >> 3) * kD + 8 * (lane & 7));
#define RW_DMA(ch_) do { const u16* g_ = rws + (size_t)(ch_) * 16 * kRWS; \
        _Pragma("unroll") for (int T_ = 0; T_ < 7; ++T_) _Pragma("unroll") for (int rb_ = 0; rb_ < 2; ++rb_) glds16(g_ + (512 * T_ + 8 * rb_ * kRWS) + dma_off, RAW + T_ * 1024 + rb_ * 512, lane); } while (0)
    RW_DMA(0);
    wave_sync();
#pragma unroll 1
    for (int ch = 0; ch < NCH; ++ch) {
        const int t0 = ch * 16;
        wait_vm0(); wave_sync();
        float Wc = 1.f;
#pragma unroll 4
        for (int j = 0; j < 16; j += 2) {
            float al[2], be[2], ka[2], rh[2], rk2[2]; u16 vb[2];
#pragma unroll
            for (int u = 0; u < 2; ++u) {
                const int o = (j + u) * 64 + d;
                const float rv = bf2f(RAW[o]), wv = bf2f(RAW[1024 + o]), kv = bf2f(RAW[2048 + o]), kkv = bf2f(RAW[4096 + o]), bv = bf2f(RAW[5120 + o]); vb[u] = RAW[3072 + o];
                al[u] = kkv * Wc; Wc *= wv; const float iw = frcp(Wc);
                be[u] = bv * iw; ka[u] = kv * iw; rh[u] = rv * Wc; rk2[u] = rv * rkd;
            }
            const unsigned pa = cvtpk(al[0], al[1]), pb = cvtpk(be[0], be[1]), pk = cvtpk(ka[0], ka[1]), pr = cvtpk(rh[0], rh[1]), pq = cvtpk(rk2[0], rk2[1]), pn = cvtpk(-be[0], -be[1]);
            AL[j * 72 + d] = (u16)(pa & 0xffffu); AL[(j + 1) * 72 + d] = (u16)(pa >> 16); BE[j * 72 + d] = (u16)(pb & 0xffffu); BE[(j + 1) * 72 + d] = (u16)(pb >> 16);
            KA[j * 72 + d] = (u16)(pk & 0xffffu); KA[(j + 1) * 72 + d] = (u16)(pk >> 16); RH[j * 72 + d] = (u16)(pr & 0xffffu); RH[(j + 1) * 72 + d] = (u16)(pr >> 16);
            RK[j * 72 + d] = (u16)(pq & 0xffffu); RK[(j + 1) * 72 + d] = (u16)(pq >> 16);
            *(LAS unsigned*)(BET + d * 16 + j) = pn; *(LAS unsigned*)(KAT + d * 16 + j) = pk; *(LAS unsigned*)(VT + d * 16 + j) = (unsigned)vb[0] | ((unsigned)vb[1] << 16);
        }
        DEC[d] = Wc;
        wave_sync();
        {
            bf16x8 fa[2], fb[2], fk[2], fr[2];
#pragma unroll
            for (int ks = 0; ks < 2; ++ks) { fa[ks] = ldsfrag(AL, 72, c, 32 * ks + 8 * q); fb[ks] = ldsfrag(BE, 72, c, 32 * ks + 8 * q); fk[ks] = ldsfrag(KA, 72, c, 32 * ks + 8 * q); fr[ks] = ldsfrag(RH, 72, c, 32 * ks + 8 * q); }
            f32x4 mA = {0.f, 0.f, 0.f, 0.f}, mB = mA, mC = mA, mD = mA;
#pragma unroll
            for (int ks = 0; ks < 2; ++ks) { mA = mfma16(fb[ks], fa[ks], mA); mB = mfma16(fk[ks], fa[ks], mB); mC = mfma16(fb[ks], fr[ks], mC); mD = mfma16(fk[ks], fr[ks], mD); }
            const int sb = 4 * q;
            *(LAS f32x4*)(AF + c * 16 + sb) = (f32x4){sb < c ? mA[0] : 0.f, sb + 1 < c ? mA[1] : 0.f, sb + 2 < c ? mA[2] : 0.f, sb + 3 < c ? mA[3] : 0.f};
            u32x2 w2;
            w2.x = cvtpk(sb < c ? mB[0] : 0.f, sb + 1 < c ? mB[1] : 0.f); w2.y = cvtpk(sb + 2 < c ? mB[2] : 0.f, sb + 3 < c ? mB[3] : 0.f); *(LAS u32x2*)(BM + c * 16 + sb) = w2;
            w2.x = cvtpk(sb <= c ? -mC[0] : 0.f, sb + 1 <= c ? -mC[1] : 0.f); w2.y = cvtpk(sb + 2 <= c ? -mC[2] : 0.f, sb + 3 <= c ? -mC[3] : 0.f); *(LAS u32x2*)(CM + c * 16 + sb) = w2;
            w2.x = cvtpk(sb <= c ? mD[0] : 0.f, sb + 1 <= c ? mD[1] : 0.f); w2.y = cvtpk(sb + 2 <= c ? mD[2] : 0.f, sb + 3 <= c ? mD[3] : 0.f); *(LAS u32x2*)(DM + c * 16 + sb) = w2;
        }
        float bonus[4];
        {
            f32x4 mb = {0.f, 0.f, 0.f, 0.f};
#pragma unroll
            for (int ks = 0; ks < 2; ++ks) mb = mfma16(ldsfrag(RK, 72, c, 32 * ks + 8 * q), ldsfrag(RAW + 2048, 64, c, 32 * ks + 8 * q), mb);
#pragma unroll
            for (int i = 0; i < 4; ++i) bonus[i] = sum16(c == 4 * q + i ? mb[i] : 0.f);
        }
        unsigned vg[4][4];
#pragma unroll
        for (int i = 0; i < 4; ++i)
#pragma unroll
            for (int tv = 0; tv < 4; ++tv) { const int o = (4 * q + i) * 64 + 16 * tv + c; vg[i][tv] = (unsigned)RAW[3072 + o] | ((unsigned)RAW[6144 + o] << 16); }
        wave_sync();
        if (ch + 1 < NCH) RW_DMA(ch + 1);
        {
            float t[16];
            const int scol = lane & 15;
            f32x4 af[16][4];
#pragma unroll
            for (int j = 1; j < 16; ++j)
#pragma unroll
                for (int m4 = 0; m4 < (j + 3) / 4; ++m4) af[j][m4] = *(const LAS f32x4*)(AF + j * 16 + 4 * m4);
#pragma unroll
            for (int j = 0; j < 16; ++j) {
                float acc0 = (j == scol) ? 1.f : 0.f, acc1 = 0.f;
#pragma unroll
                for (int m = 0; m < j; ++m) { if (m & 1) acc1 -= af[j][m >> 2][m & 3] * t[m]; else acc0 -= af[j][m >> 2][m & 3] * t[m]; }
                t[j] = acc0 + acc1;
            }
            if (lane < 16) {
#pragma unroll
                for (int j = 0; j < 16; ++j) TI[j * 16 + scol] = (u16)(cvtpk(t[j], 0.f) & 0xffffu); }
        }
        wave_sync();
        {
            const bf16x8 a0 = ldsfrag(AL, 72, c, 8 * q), a1 = ldsfrag(AL, 72, c, 32 + 8 * q), bm = fragT(BM, ZERO, c, q);
#pragma unroll
            for (int tv = 0; tv < 4; ++tv) { const int row = 16 * tv + c;
                f32x4 z = {0.f, 0.f, 0.f, 0.f};
                z = mfma16(a0, ldsfrag(SI, 72, row, 8 * q), z); z = mfma16(a1, ldsfrag(SI, 72, row, 32 + 8 * q), z); z = mfma16(bm, fragT(VT, ZERO, row, q), z);
                u32x2 w2; w2.x = cvtpk(z[0], z[1]); w2.y = cvtpk(z[2], z[3]); *(LAS u32x2*)(ZT + row * 16 + 4 * q) = w2; }
        }
        wave_sync();
        {
            const bf16x8 ti = fragT(TI, ZERO, c, q);
#pragma unroll
            for (int tv = 0; tv < 4; ++tv) { const int row = 16 * tv + c;
                f32x4 u = {0.f, 0.f, 0.f, 0.f};
                u = mfma16(ti, fragT(ZT, ZERO, row, q), u);
                u32x2 w2; w2.x = cvtpk(u[0], u[1]); w2.y = cvtpk(u[2], u[3]); *(LAS u32x2*)(UT + row * 16 + 4 * q) = w2; }
        }
        wave_sync();
        {
            const bf16x8 r0 = ldsfrag(RH, 72, c, 8 * q), r1 = ldsfrag(RH, 72, c, 32 + 8 * q), cm = fragT(CM, ZERO, c, q), dm = fragT(DM, ZERO, c, q);
            f32x4 y[4];
#pragma unroll
            for (int tv = 0; tv < 4; ++tv) { const int row = 16 * tv + c;
                f32x4 a = {0.f, 0.f, 0.f, 0.f};
                a = mfma16(r0, ldsfrag(SI, 72, row, 8 * q), a); a = mfma16(r1, ldsfrag(SI, 72, row, 32 + 8 * q), a);
                a = mfma16(cm, fragT(UT, ZERO, row, q), a); a = mfma16(dm, fragT(VT, ZERO, row, q), a);
                y[tv] = a; }
#pragma unroll
            for (int i = 0; i < 4; ++i) {
                const float mean = sum16((y[0][i] + y[1][i]) + (y[2][i] + y[3][i])) * (1.0f / 64.0f);
                const float d0 = y[0][i] - mean, d1 = y[1][i] - mean, d2 = y[2][i] - mean, d3 = y[3][i] - mean;
                const float var = sum16((d0 * d0 + d1 * d1) + (d2 * d2 + d3 * d3)) * (1.0f / 64.0f);
                const float rstd = frsq(var + kRwkvLnEps);
                const float dd[4] = {d0, d1, d2, d3};
#pragma unroll
                for (int tv = 0; tv < 4; ++tv) { const float vv = bf2f((u16)(vg[i][tv] & 0xffffu)), gg = bf2f((u16)(vg[i][tv] >> 16));
                    OT[(4 * q + i) * 64 + 16 * tv + c] = (u16)(cvtpk((dd[tv] * rstd * lnw[tv] + lnb[tv] + bonus[i] * vv) * gg, 0.f) & 0xffffu); }
            }
        }
        wave_sync();
#pragma unroll
        for (int i = 0; i < 2; ++i) { const int row = 8 * i + (lane >> 3), cg = lane & 7;
            *(u32x4*)(ochain + (size_t)(t0 + 8 * i) * kD + st_off) = *(const LAS u32x4*)(OT + row * 64 + 8 * cg); }
        {
            bf16x8 ut[4], vt[4];
#pragma unroll
            for (int tv = 0; tv < 4; ++tv) { ut[tv] = fragT(UT, ZERO, 16 * tv + c, q); vt[tv] = fragT(VT, ZERO, 16 * tv + c, q); }
#pragma unroll
            for (int tk = 0; tk < 4; ++tk) {
                const bf16x8 nb = fragT(BET, ZERO, 16 * tk + c, q), kt = fragT(KAT, ZERO, 16 * tk + c, q);
                const f32x4 dv = *(const LAS f32x4*)(DEC + 16 * tk + 4 * q);
#pragma unroll
                for (int tv = 0; tv < 4; ++tv) {
                    f32x4 h = mfma16(nb, ut[tv], accH[tk][tv]); h = mfma16(kt, vt[tv], h);
                    h = h * dv; accH[tk][tv] = h;
                    u32x2 w2; w2.x = cvtpk(h[0], h[1]); w2.y = cvtpk(h[2], h[3]);
                    *(LAS u32x2*)(SI + (16 * tv + c) * 72 + 16 * tk + 4 * q) = w2;
                }
            }
        }
        wave_sync();
    }
#undef RW_DMA
}

#ifndef KMASK
#define KMASK 15
#endif
#ifndef RWKV_CHUNKED
#define RWKV_CHUNKED 0
#endif
DEV void mix_phase(Frame& F, int l) {
#if RWKV_CHUNKED
    constexpr int NCHAIN = 4 * kB * kH, NITEM = (NCHAIN + 2) / 3;
    for (int item = F.bid; item < NITEM; item += F.G) {
        const int cid = item * 3 + F.wave;
#ifndef HOST_EMU
        if (F.wave >= 3) {
            if (l == 0) for (int it = CV_N0 + CV_N1 + item * 5 + (F.wave - 3); it < CV_NT; it += NITEM * 5) conv_wave_tile(F, 0, it, F.lane);
            if (l + 1 < kL) for (int it = item * 5 + (F.wave - 3); it < CV_NT; it += NITEM * 5) conv_wave_tile(F, l + 1, it, F.lane);
        }
#endif
        if (F.wave < 3 && cid < NCHAIN) {
            const int kind = cid % 4, r = cid / 4;
            LAS unsigned char* wl = F.lds + F.wave * CL_BYTES;
            if ((KMASK & 1) && kind == 0) chain_abc<0>(F, wl, l, r / kH, r % kH);
            else if ((KMASK & 2) && kind == 1) chain_abc<1>(F, wl, l, r / kH, r % kH);
            else if ((KMASK & 4) && kind == 2) chain_abc<2>(F, wl, l, r / kH, r % kH);
            else if ((KMASK & 8) && kind == 3) chain_rwkv(F, wl, l, r / kH, r % kH);
        }
        __syncthreads();
    }
#else
    constexpr int NRW = kB * kH, NABC = 3 * kB * kH, NITEM = NRW + (NABC + 2) / 3;
    for (int item = F.bid; item < NITEM; item += F.G) {
        if (item < NRW) { if (KMASK & 8) rwkv_scan(F, l, item / kH, item % kH); }
        else {
            const int cid = (item - NRW) * 3 + F.wave;
#ifndef HOST_EMU
            if (F.wave >= 3) {
                if (l == 0) for (int it = CV_N0 + CV_N1 + (item - NRW) * 5 + (F.wave - 3); it < CV_NT; it += (NITEM - NRW) * 5) conv_wave_tile(F, 0, it, F.lane);
                if (l + 1 < kL) for (int it = (item - NRW) * 5 + (F.wave - 3); it < CV_NT; it += (NITEM - NRW) * 5) conv_wave_tile(F, l + 1, it, F.lane);
            }
#endif
            if (F.wave < 3 && cid < NABC) {
                const int kind = cid / (kB * kH), r = cid % (kB * kH);
                LAS unsigned char* wl = F.lds + F.wave * CL_BYTES;
                if ((KMASK & 1) && kind == 0) chain_abc<0>(F, wl, l, r / kH, r % kH);
                else if ((KMASK & 2) && kind == 1) chain_abc<1>(F, wl, l, r / kH, r % kH);
                else if ((KMASK & 4) && kind == 2) chain_abc<2>(F, wl, l, r / kH, r % kH);
            }
            __syncthreads();
        }
    }
#endif
}

template <int MODE> DEV void simple_gemm_phase(Frame& F, const u16* A, const u16* Bt, int M, int N, int K, u16* O, int ldo) {
    LAS u16* As = (LAS u16*)F.lds;
    LAS u16* Bs = (LAS u16*)F.lds + 128 * 40;
    const int c = F.lane & 15, q = F.lane >> 4, w = F.wave;
    const int NT = MODE == 0 ? N / 64 : N / 128, MT = M / 128;
    for (int tile = F.bid; tile < MT * NT; tile += F.G) {
        const int tm = tile / NT, tn = tile % NT;
        f32x4 acc[2][4];
#pragma unroll
        for (int h = 0; h < 2; ++h)
#pragma unroll
            for (int j = 0; j < 4; ++j) acc[h][j] = (f32x4){0.f, 0.f, 0.f, 0.f};
        for (int k0 = 0; k0 < K; k0 += 32) {
            { const int r = F.tid >> 2, g = F.tid & 3; *(LAS u32x4*)(As + r * 40 + 8 * g) = *(const u32x4*)(A + (size_t)(tm * 128 + r) * K + k0 + 8 * g); }
            if (MODE == 0) { if (F.tid < 256) { const int r = F.tid >> 2, g = F.tid & 3; *(LAS u32x4*)(Bs + r * 40 + 8 * g) = *(const u32x4*)(Bt + (size_t)(tn * 64 + r) * K + k0 + 8 * g); } }
            else { const int r = F.tid >> 2, g = F.tid & 3; const int un = tn >> 1, off = (tn & 1) * 64; const int brow = un * 256 + (r < 64 ? off + r : 128 + off + (r - 64));
                *(LAS u32x4*)(Bs + r * 40 + 8 * g) = *(const u32x4*)(Bt + (size_t)brow * K + k0 + 8 * g); }
            __syncthreads();
            const bf16x8 af = ldsfrag(As, 40, 16 * w + c, 8 * q);
#pragma unroll
            for (int h = 0; h < (MODE == 0 ? 1 : 2); ++h)
#pragma unroll
                for (int j = 0; j < 4; ++j) acc[h][j] = mfma16(af, ldsfrag(Bs, 40, 64 * h + 16 * j + c, 8 * q), acc[h][j]);
            __syncthreads();
        }
#pragma unroll
        for (int j = 0; j < 4; ++j)
#pragma unroll
            for (int i = 0; i < 4; ++i) { const size_t row = (size_t)tm * 128 + 16 * w + 4 * q + i; const int col = tn * 64 + 16 * j + c;
                if (MODE == 0) O[row * ldo + col] = f2bf(acc[0][j][i]);
                else { const float g = acc[0][j][i], up = acc[1][j][i]; O[row * ldo + col] = f2bf(g / (1.0f + expf(-g)) * up); } }
    }
}

#ifndef HOST_EMU
__device__ __forceinline__ unsigned xb_ld(unsigned* p);
__device__ __forceinline__ unsigned xb_add(unsigned* p, unsigned v);
namespace pg8 {
#define PG8_LAS __attribute__((address_space(3)))
typedef unsigned short bf16_t;
constexpr int BM = 256, BK = 64, HALF = 128, HTB = HALF * BK * 2, STAGE_BYTES = 8 * HTB, NXCD = 8, WGM = 8;
__host__ __device__ __forceinline__ int lds_byte(int r, int c) { const int st = (r >> 4) * 2 + (c >> 5), rr = r & 15, cc = c & 31, ob = rr * 64 + cc * 2; return st * 1024 + (ob ^ (((ob >> 9) & 1) << 5)); }
__host__ __device__ __forceinline__ void stage_rc(int b, int& R, int& C) { const int st = b / 1024, sb = b % 1024, swz = sb ^ (((sb >> 9) & 1) << 5); R = (st >> 1) * 16 + swz / 64; C = (st & 1) * 32 + (swz % 64) / 2; }
__host__ __device__ __forceinline__ int perm32(int rho) { const int n = rho >> 4, i = rho & 15; return 8 * (i >> 2) + 4 * n + (i & 3); }
struct Unit { int pm, pn; };
struct Gemm { const bf16_t* A; const bf16_t* Bt; int M, N, K; };
struct StaticOrder {
    int nM, nN, nwg, G, c;
    __host__ __device__ void init(int M, int N, int G_, int c_) { nM = M / BM; nN = N / BM; nwg = nM * nN; G = G_; c = c_; }
    __host__ __device__ bool next(int i, Unit& u) const {
        const long L = (long)i * G + c; if (L >= nwg) return false;
        int wgid = (int)L; { const int q = nwg / NXCD, r = nwg % NXCD, xcd = wgid % NXCD, off = wgid / NXCD; wgid = (xcd < r ? xcd * (q + 1) : r * (q + 1) + (xcd - r) * q) + off; }
        const int nig = WGM * nN, gid = wgid / nig, fm = gid * WGM, gsz = (nM - fm) < WGM ? (nM - fm) : WGM;
        u.pm = fm + ((wgid % nig) % gsz); u.pn = (wgid % nig) / gsz; return true;
    }
    __device__ __forceinline__ void a_ready(const Unit&) const {}
    __device__ __forceinline__ void done(const Unit&) const {}
};
__device__ __forceinline__ unsigned cvt_pk_bf16(float lo, float hi) { unsigned r; asm volatile("v_cvt_pk_bf16_f32 %0, %1, %2" : "=v"(r) : "v"(lo), "v"(hi)); return r; }
template <bool SCALE> struct EpiBf16 {
    static constexpr bool PERM = true, AFTER_DRAIN = false, HAS_SCALE = SCALE;
    bf16_t* O; int ldc; const float* rs; PG8_LAS float* scl;
    __device__ __forceinline__ void prefetch(const Unit& u, int par, int wid, int lane) const {
        if (SCALE && wid < 4) __builtin_amdgcn_global_load_lds((const unsigned*)(rs + u.pm * BM + 64 * wid + lane), (PG8_LAS unsigned*)(scl + par * 256 + 64 * wid), 4, 0, 0); }
    __device__ __forceinline__ void operator()(const f32x4 (&acc)[2][2][4][2], const Unit& u, int wr, int wc, int fr, int fq, int par) const {
        const int row0 = u.pm * BM + wr * 64 + fr; const int col0 = u.pn * BM + wc * 32 + 8 * fq;
#pragma unroll
        for (int ai = 0; ai < 2; ++ai)
#pragma unroll
            for (int m = 0; m < 4; ++m) { bf16_t* rowp = O + (size_t)(row0 + ai * HALF + m * 16) * ldc + col0; const float sc = SCALE ? scl[par * 256 + wr * 64 + fr + ai * HALF + m * 16] : 1.0f;
#pragma unroll
                for (int bj = 0; bj < 2; ++bj) { const f32x4 v0 = acc[ai][bj][m][0] * sc, v1 = acc[ai][bj][m][1] * sc;
                    u32x4 w; w.x = cvt_pk_bf16(v0[0], v0[1]); w.y = cvt_pk_bf16(v0[2], v0[3]); w.z = cvt_pk_bf16(v1[0], v1[1]); w.w = cvt_pk_bf16(v1[2], v1[3]);
                    if (SCALE) __builtin_nontemporal_store(w, (u32x4*)(rowp + bj * HALF)); else *(u32x4*)(rowp + bj * HALF) = w; } }
    }
};
struct EpiSwiGlu {
    static constexpr bool PERM = true, AFTER_DRAIN = false, HAS_SCALE = true;
    bf16_t* O; int ldc; const float* rs; PG8_LAS float* scl;
    __device__ __forceinline__ void prefetch(const Unit& u, int par, int wid, int lane) const {
        if (wid < 4) __builtin_amdgcn_global_load_lds((const unsigned*)(rs + u.pm * BM + 64 * wid + lane), (PG8_LAS unsigned*)(scl + par * 256 + 64 * wid), 4, 0, 0); }
    __device__ __forceinline__ void operator()(const f32x4 (&acc)[2][2][4][2], const Unit& u, int wr, int wc, int fr, int fq, int par) const {
        const int row0 = u.pm * BM + wr * 64 + fr; const int col0 = u.pn * HALF + wc * 32 + 8 * fq;
#pragma unroll
        for (int ai = 0; ai < 2; ++ai)
#pragma unroll
            for (int m = 0; m < 4; ++m) { bf16_t* rowp = O + (size_t)(row0 + ai * HALF + m * 16) * ldc + col0; const float sc = scl[par * 256 + wr * 64 + fr + ai * HALF + m * 16];
                float o[8];
#pragma unroll
                for (int n = 0; n < 2; ++n)
#pragma unroll
                    for (int j = 0; j < 4; ++j) { const float g = acc[ai][0][m][n][j] * sc, up = acc[ai][1][m][n][j] * sc; o[4 * n + j] = g * __builtin_amdgcn_rcpf(1.0f + __expf(-g)) * up; }
                u32x4 w; w.x = cvt_pk_bf16(o[0], o[1]); w.y = cvt_pk_bf16(o[2], o[3]); w.z = cvt_pk_bf16(o[4], o[5]); w.w = cvt_pk_bf16(o[6], o[7]);
                __builtin_nontemporal_store(w, (u32x4*)rowp); }
    }
};

struct PanelOrder {
    int nM, ngrp, g, pn;
    __device__ void init(int M, int G_, int c_) { nM = M / BM; ngrp = G_ / 8;
        if (G_ % 64 == 0) { const int x = c_ & 7, j = c_ >> 3; g = x + 8 * (j >> 3); pn = j & 7; } else { g = c_ >> 3; pn = c_ & 7; }
        if (c_ >= 8 * ngrp) g = 1 << 28; }
    __device__ bool next(int i, Unit& u) const { const long pm = (long)i * ngrp + g; if (pm >= nM) return false; u.pm = (int)pm; u.pn = pn; return true; }
    __device__ __forceinline__ void a_ready(const Unit&) const {}
    __device__ __forceinline__ void done(const Unit&) const {}
};
#define PG8_EPI_BAR() do { asm volatile("s_waitcnt vmcnt(0) lgkmcnt(0)" ::: "memory"); __builtin_amdgcn_s_barrier(); } while (0)
template <bool FINAL> struct EpiResNorm {
    static constexpr bool PERM = true, AFTER_DRAIN = false, HAS_SCALE = false;
    float* OUT; bf16_t* H; const float* gy; float* XP; float* XQ; float* R2; unsigned* cnt; unsigned* tmo; PG8_LAS float* red;
    __device__ __forceinline__ void prefetch(const Unit&, int, int, int) const {}
    __device__ __forceinline__ float rowsum(int row) const { float t = 0.f;
#pragma unroll
        for (int s_ = 0; s_ < 16; ++s_) t += red[s_ * 256 + row];
        return t; }
    static __device__ __forceinline__ void xst(float* p, float v) { __hip_atomic_store(p, v, __ATOMIC_RELAXED, __HIP_MEMORY_SCOPE_AGENT); }
    static __device__ __forceinline__ float xld(const float* p) { return __hip_atomic_load(p, __ATOMIC_RELAXED, __HIP_MEMORY_SCOPE_AGENT); }
    static __device__ __forceinline__ float sum8x(const float* p) { float v[8];
#pragma unroll
        for (int i = 0; i < 8; ++i) v[i] = xld(p + i);
        return ((v[0] + v[1]) + (v[2] + v[3])) + ((v[4] + v[5]) + (v[6] + v[7])); }
    __device__ __forceinline__ void operator()(const f32x4 (&acc)[2][2][4][2], const Unit& u, int wr, int wc, int fr_, int fq_, int) const {
        int fr = fr_, fq = fq_; asm volatile("" : "+v"(fr), "+v"(fq));
        const int tid = (wr * 4 + wc) * 64 + fq * 16 + fr, slot = (wc * 4 + fq) * 256;
        PG8_LAS float* tab = red + 16 * 256; volatile PG8_LAS unsigned* flag = (volatile PG8_LAS unsigned*)(red + 17 * 256);
        const size_t prow = (size_t)u.pm * BM;
        const int col0 = u.pn * BM + wc * 32 + 8 * fq;
        u32x4 hq[2][4][2];
#pragma unroll
        for (int ai = 0; ai < 2; ++ai)
#pragma unroll
            for (int m = 0; m < 4; ++m) { const bf16_t* rp = H + (prow + ai * HALF + wr * 64 + m * 16 + fr) * 2048 + col0; hq[ai][m][0] = *(const u32x4*)rp; hq[ai][m][1] = *(const u32x4*)(rp + HALF); }
#pragma unroll
        for (int ai = 0; ai < 2; ++ai)
#pragma unroll
            for (int m = 0; m < 4; ++m) { float s_ = 0.f;
#pragma unroll
                for (int bj = 0; bj < 2; ++bj)
#pragma unroll
                    for (int n = 0; n < 2; ++n) { const f32x4 v = acc[ai][bj][m][n]; s_ += (v[0] * v[0] + v[1] * v[1]) + (v[2] * v[2] + v[3] * v[3]); }
                red[slot + ai * HALF + wr * 64 + m * 16 + fr] = s_; }
        asm volatile("s_waitcnt lgkmcnt(0)" ::: "memory"); __builtin_amdgcn_s_barrier();
        if (tid < 256) { xst(XP + (prow + tid) * 8 + u.pn, rowsum(tid)); asm volatile("s_waitcnt vmcnt(0)" ::: "memory"); }
        __builtin_amdgcn_s_barrier();
        if (tid == 0) { unsigned* c_ = cnt + u.pm; asm volatile("" : "+s"(c_));
            (void)xb_add(c_, 1u);
            { unsigned sp_ = 0; while (xb_ld(c_) < 8u) { __builtin_amdgcn_s_sleep(1); if ((++sp_ & 255u) == 0u) { if (xb_ld(tmo)) break; if (sp_ > (1u << 27)) { atomicAdd(tmo, 1u); break; } } } } }
        f32x4 gv[2][2];
#pragma unroll
        for (int bj = 0; bj < 2; ++bj) { gv[bj][0] = *(const f32x4*)(gy + col0 + bj * HALF); gv[bj][1] = *(const f32x4*)(gy + col0 + bj * HALF + 4); }
        asm volatile("s_waitcnt lgkmcnt(0)" ::: "memory"); __builtin_amdgcn_s_barrier();
        if (tid < 256) tab[tid] = 1.0f / sqrtf(sum8x(XP + (prow + tid) * 8) * (1.0f / 2048.0f) + 1e-6f);
        asm volatile("s_waitcnt lgkmcnt(0)" ::: "memory"); __builtin_amdgcn_s_barrier();
#pragma unroll
        for (int ai = 0; ai < 2; ++ai)
#pragma unroll
            for (int m = 0; m < 4; ++m) { const int rl = ai * HALF + wr * 64 + m * 16 + fr; const float rs = tab[rl]; bf16_t* rowp = H + (prow + rl) * 2048 + col0; float hs = 0.f;
#pragma unroll
                for (int bj = 0; bj < 2; ++bj) { const u32x4 hv = hq[ai][m][bj];
                    const f32x4 y0 = acc[ai][bj][m][0] * rs * gv[bj][0], y1 = acc[ai][bj][m][1] * rs * gv[bj][1];
                    float o[8];
                    o[0] = __builtin_bit_cast(float, hv.x << 16) + y0[0]; o[1] = __builtin_bit_cast(float, hv.x & 0xffff0000u) + y0[1]; o[2] = __builtin_bit_cast(float, hv.y << 16) + y0[2]; o[3] = __builtin_bit_cast(float, hv.y & 0xffff0000u) + y0[3];
                    o[4] = __builtin_bit_cast(float, hv.z << 16) + y1[0]; o[5] = __builtin_bit_cast(float, hv.z & 0xffff0000u) + y1[1]; o[6] = __builtin_bit_cast(float, hv.w << 16) + y1[2]; o[7] = __builtin_bit_cast(float, hv.w & 0xffff0000u) + y1[3];
#pragma unroll
                    for (int j = 0; j < 8; ++j) hs += o[j] * o[j];
                    if (FINAL) { float* op = OUT + (prow + rl) * 2048 + col0 + bj * HALF;
                        __builtin_nontemporal_store((f32x4){o[0], o[1], o[2], o[3]}, (f32x4*)op); __builtin_nontemporal_store((f32x4){o[4], o[5], o[6], o[7]}, (f32x4*)(op + 4)); }
                    else { u32x4 w; w.x = cvt_pk_bf16(o[0], o[1]); w.y = cvt_pk_bf16(o[2], o[3]); w.z = cvt_pk_bf16(o[4], o[5]); w.w = cvt_pk_bf16(o[6], o[7]);
                        *(u32x4*)(rowp + bj * HALF) = w; } }
                if (!FINAL) red[slot + rl] = hs; }
        if (FINAL) return;
        asm volatile("s_waitcnt lgkmcnt(0)" ::: "memory"); __builtin_amdgcn_s_barrier();
        if (tid < 256) { xst(XQ + (prow + tid) * 8 + u.pn, rowsum(tid)); asm volatile("s_waitcnt vmcnt(0)" ::: "memory"); }
        __builtin_amdgcn_s_barrier();
        if (tid == 0) { unsigned* c_ = cnt + 128 + u.pm; asm volatile("" : "+s"(c_));
            const unsigned old = xb_add(c_, 1u);
            flag[0] = old == 7u ? 1u : 0u; }
        asm volatile("s_waitcnt lgkmcnt(0)" ::: "memory"); __builtin_amdgcn_s_barrier();
        if (flag[0] != 0u && tid < 256) R2[prow + tid] = 1.0f / sqrtf(sum8x(XQ + (prow + tid) * 8) * (1.0f / 2048.0f) + 1e-6f);
        asm volatile("s_waitcnt lgkmcnt(0)" ::: "memory"); __builtin_amdgcn_s_barrier();
    }
};

template <class Epi, class Sched, bool ALIGN_EPI = false, bool SP2 = false>
__device__ __forceinline__ void gemm_phase(PG8_LAS unsigned char* lds, const Gemm g, const Sched& S, const Epi& E, const int tid) {
    const int wid = __builtin_amdgcn_readfirstlane(tid >> 6), lane = tid & 63, wr = wid >> 2, wc = wid & 3, fr = lane & 15, fq = lane >> 4;
    const int K = g.K, nt = K / BK;
    unsigned voffA[2], voffB[2];
#pragma unroll
    for (int i = 0; i < 2; ++i) { int R, C; stage_rc(tid * 16 + i * 8192, R, C); const int Rb = Epi::PERM ? ((R & ~31) + perm32(R & 31)) : R;
        voffA[i] = (unsigned)(R * K + C) * 2u; voffB[i] = (unsigned)(Rb * K + C) * 2u; }
    const size_t kstep = (size_t)(BK * 2);
    const size_t hstep = (size_t)HALF * K * 2;
    const size_t tstep = 2 * hstep;
    const unsigned ldsw = (unsigned)wid * 1024u;
    const int aoff = lds_byte(wr * 64 + fr, fq * 8), boff = lds_byte(wc * 32 + fr, fq * 8);
#define PG8_SA(b, h) (((b) * 2 + (h)) * HTB)
#define PG8_SB(b, h) ((4 + (b) * 2 + (h)) * HTB)
#define PG8_STAGE(bufoff, gbase, voff) do { _Pragma("unroll") for (int _i = 0; _i < 2; ++_i) \
        __builtin_amdgcn_global_load_lds((const unsigned*)((const char*)(gbase) + (voff)[_i]), (PG8_LAS unsigned*)(lds + (bufoff) + ldsw + _i * 8192), 16, 0, 0); } while (0)
#define PG8_LDA(dst, b, h) do { _Pragma("unroll") for (int m = 0; m < 4; ++m) _Pragma("unroll") for (int k = 0; k < 2; ++k) dst[m][k] = *(const PG8_LAS bf16x8*)(lds + PG8_SA(b, h) + aoff + m * 2048 + k * 1024); } while (0)
#define PG8_LDB(dst, b, h) do { _Pragma("unroll") for (int n = 0; n < 2; ++n) _Pragma("unroll") for (int k = 0; k < 2; ++k) dst[n][k] = *(const PG8_LAS bf16x8*)(lds + PG8_SB(b, h) + boff + n * 2048 + k * 1024); } while (0)
#define PG8_MMA(ai, bj, At, Bt) do { __builtin_amdgcn_s_setprio(1); _Pragma("unroll") for (int m = 0; m < 4; ++m) _Pragma("unroll") for (int n = 0; n < 2; ++n) _Pragma("unroll") for (int k = 0; k < 2; ++k) \
        acc[ai][bj][m][n] = __builtin_amdgcn_mfma_f32_16x16x32_bf16(Bt[n][k], At[m][k], acc[ai][bj][m][n], 0, 0, 0); __builtin_amdgcn_s_setprio(0); } while (0)
#define PG8_WAIT_V(n) asm volatile("s_waitcnt vmcnt(" #n ")" ::: "memory")
#define PG8_WAIT_L(n) asm volatile("s_waitcnt lgkmcnt(" #n ")" ::: "memory")
#define PG8_BAR __builtin_amdgcn_s_barrier()
#define PG8_SCHED __builtin_amdgcn_sched_barrier(0)
    Unit cur, nxt; int ui = 0;
    if (!S.next(0, cur)) return;
    f32x4 acc[2][2][4][2];
#pragma unroll
    for (int a = 0; a < 2; ++a)
#pragma unroll
        for (int b = 0; b < 2; ++b)
#pragma unroll
            for (int m = 0; m < 4; ++m)
#pragma unroll
                for (int n = 0; n < 2; ++n) acc[a][b][m][n] = (f32x4){0.f, 0.f, 0.f, 0.f};
    bf16x8 At[4][2], B0[2][2], B1[2][2];
    const char* cA = (const char*)g.A + (size_t)cur.pm * tstep; const char* cB = (const char*)g.Bt + (size_t)cur.pn * tstep;
    S.a_ready(cur);
    if constexpr (Epi::HAS_SCALE) E.prefetch(cur, 0, wid, lane);
    if constexpr (SP2) {
        PG8_STAGE(PG8_SB(0, 0), cB, voffB); PG8_STAGE(PG8_SB(0, 1), cB + hstep, voffB); PG8_STAGE(PG8_SA(0, 0), cA, voffA); PG8_STAGE(PG8_SA(0, 1), cA + hstep, voffA);
        if (wr == 1) PG8_BAR;
        PG8_WAIT_V(2); PG8_BAR;
        PG8_STAGE(PG8_SB(1, 0), cB + kstep, voffB); PG8_STAGE(PG8_SA(1, 0), cA + kstep, voffA); PG8_STAGE(PG8_SB(1, 1), cB + hstep + kstep, voffB);
        PG8_WAIT_V(6); PG8_BAR;
    } else {
        PG8_STAGE(PG8_SB(0, 0), cB, voffB); PG8_STAGE(PG8_SA(0, 0), cA, voffA); PG8_STAGE(PG8_SB(0, 1), cB + hstep, voffB); PG8_STAGE(PG8_SA(0, 1), cA + hstep, voffA);
        if (wr == 1) PG8_BAR;
        PG8_WAIT_V(4); PG8_BAR;
        PG8_STAGE(PG8_SB(1, 0), cB + kstep, voffB); PG8_STAGE(PG8_SA(1, 0), cA + kstep, voffA); PG8_STAGE(PG8_SB(1, 1), cB + hstep + kstep, voffB);
        PG8_WAIT_V(6); PG8_BAR;
    }
    for (;;) {
        const bool has_next = S.next(ui + 1, nxt);
        const char* nA = has_next ? (const char*)g.A + (size_t)nxt.pm * tstep : cA; const char* nB = has_next ? (const char*)g.Bt + (size_t)nxt.pn * tstep : cB;
        for (int t = 0; t < nt; t += 2) {
            const bool last = (t == nt - 2);
            const char* a1 = cA + (size_t)(t + 1) * kstep;
            const char* a2 = last ? nA : cA + (size_t)(t + 2) * kstep; const char* b2 = last ? nB : cB + (size_t)(t + 2) * kstep;
            const char* a3 = a2 + kstep; const char* b3 = b2 + kstep;
            if (last && has_next) { S.a_ready(nxt); if constexpr (Epi::HAS_SCALE) E.prefetch(nxt, (ui + 1) & 1, wid, lane); }
            if constexpr (SP2) {
            PG8_LDB(B0, 0, 0); PG8_LDB(B1, 0, 1); PG8_SCHED; PG8_LDA(At, 0, 0); PG8_STAGE(PG8_SA(1, 1), a1 + hstep, voffA);
            PG8_WAIT_V(8); PG8_WAIT_L(0); PG8_BAR; PG8_MMA(0, 0, At, B0); PG8_MMA(0, 1, At, B1); PG8_BAR; PG8_SCHED;
            PG8_LDA(At, 0, 1); PG8_STAGE(PG8_SB(0, 0), b2, voffB); PG8_STAGE(PG8_SB(0, 1), b2 + hstep, voffB); PG8_STAGE(PG8_SA(0, 0), a2, voffA);
            PG8_WAIT_V(8); PG8_WAIT_L(0); PG8_BAR; PG8_MMA(1, 0, At, B0); PG8_MMA(1, 1, At, B1); PG8_BAR; PG8_SCHED;
            PG8_LDB(B0, 1, 0); PG8_LDB(B1, 1, 1); PG8_SCHED; PG8_LDA(At, 1, 0); PG8_STAGE(PG8_SA(0, 1), a2 + hstep, voffA);
            PG8_WAIT_V(8); PG8_WAIT_L(0); PG8_BAR; PG8_MMA(0, 0, At, B0); PG8_MMA(0, 1, At, B1); PG8_BAR; PG8_SCHED;
            PG8_LDA(At, 1, 1); PG8_STAGE(PG8_SB(1, 0), b3, voffB); PG8_STAGE(PG8_SB(1, 1), b3 + hstep, voffB); PG8_STAGE(PG8_SA(1, 0), a3, voffA);
            PG8_WAIT_V(8); PG8_WAIT_L(0); PG8_BAR; PG8_MMA(1, 0, At, B0); PG8_MMA(1, 1, At, B1); PG8_BAR; PG8_SCHED;
            } else {
            PG8_LDB(B0, 0, 0); PG8_SCHED; PG8_LDA(At, 0, 0); PG8_STAGE(PG8_SA(1, 1), a1 + hstep, voffA);
            PG8_WAIT_L(8); PG8_BAR; PG8_WAIT_L(0); PG8_MMA(0, 0, At, B0); PG8_BAR; PG8_SCHED;
            PG8_LDB(B1, 0, 1); PG8_STAGE(PG8_SB(0, 0), b2, voffB);
            PG8_BAR; PG8_WAIT_L(0); PG8_MMA(0, 1, At, B1); PG8_BAR;
            PG8_LDA(At, 0, 1); PG8_STAGE(PG8_SA(0, 0), a2, voffA);
            PG8_BAR; PG8_WAIT_L(0); PG8_MMA(1, 0, At, B0); PG8_BAR; PG8_SCHED;
            PG8_STAGE(PG8_SB(0, 1), b2 + hstep, voffB);
            PG8_WAIT_V(6); PG8_BAR; PG8_MMA(1, 1, At, B1); PG8_BAR;
            PG8_LDB(B0, 1, 0); PG8_SCHED; PG8_LDA(At, 1, 0); PG8_STAGE(PG8_SA(0, 1), a2 + hstep, voffA);
            PG8_WAIT_L(8); PG8_BAR; PG8_WAIT_L(0); PG8_MMA(0, 0, At, B0); PG8_BAR; PG8_SCHED;
            PG8_LDB(B1, 1, 1); PG8_STAGE(PG8_SB(1, 0), b3, voffB);
            PG8_BAR; PG8_WAIT_L(0); PG8_MMA(0, 1, At, B1); PG8_BAR;
            PG8_LDA(At, 1, 1); PG8_STAGE(PG8_SA(1, 0), a3, voffA);
            PG8_BAR; PG8_WAIT_L(0); PG8_MMA(1, 0, At, B0); PG8_BAR; PG8_SCHED;
            PG8_STAGE(PG8_SB(1, 1), b3 + hstep, voffB);
            PG8_WAIT_V(6); PG8_BAR; PG8_MMA(1, 1, At, B1); PG8_BAR;
            }
        }
        if constexpr (ALIGN_EPI) { if (wr == 0) PG8_BAR; }
        if constexpr (!Epi::AFTER_DRAIN) { E(acc, cur, wr, wc, fr, fq, ui & 1); S.done(cur); }
        if (!has_next) break;
#pragma unroll
        for (int a = 0; a < 2; ++a)
#pragma unroll
            for (int b = 0; b < 2; ++b)
#pragma unroll
                for (int m = 0; m < 4; ++m)
#pragma unroll
                    for (int n = 0; n < 2; ++n) acc[a][b][m][n] = (f32x4){0.f, 0.f, 0.f, 0.f};
        cur = nxt; cA = nA; cB = nB; ++ui;
        if constexpr (ALIGN_EPI) { if (wr == 1) PG8_BAR; }
    }
    PG8_WAIT_V(0);
    if constexpr (!ALIGN_EPI) { if (wr == 0) PG8_BAR; }
    PG8_BAR;
#undef PG8_SA
#undef PG8_SB
#undef PG8_STAGE
#undef PG8_LDA
#undef PG8_LDB
#undef PG8_MMA
#undef PG8_WAIT_V
#undef PG8_WAIT_L
#undef PG8_BAR
#undef PG8_SCHED
}
}

#define XB_TMO      128
#define XB_XCNT(j)  (256  + 64 * (j))
#define XB_XSUB(j)  (1280 + 64 * (j))
#define XB_XGEN(j)  (2304 + 64 * (j))
#define XB_TOP      3328
#define XB_TOPGEN   3392
#define XCD_BAR_WORDS 3456
#define XB_SPIN_CAP (1u << 27)
__device__ __forceinline__ unsigned xb_ld(unsigned* p)              { return __hip_atomic_load(p, __ATOMIC_RELAXED, __HIP_MEMORY_SCOPE_AGENT); }
__device__ __forceinline__ unsigned xb_add(unsigned* p, unsigned v) { return __hip_atomic_fetch_add(p, v, __ATOMIC_RELAXED, __HIP_MEMORY_SCOPE_AGENT); }
__device__ __forceinline__ unsigned xb_xcc_id() { return (unsigned)__builtin_amdgcn_s_getreg((3 << 11) | 20) & 0xFu; }
#define XB_SPIN(cond, bar) do { unsigned _sp = 0; while (cond) { __builtin_amdgcn_s_sleep(1); \
    if ((++_sp & 255u) == 0u) { if (xb_ld(&(bar)[XB_TMO])) break; if (_sp > XB_SPIN_CAP) { atomicAdd(&(bar)[XB_TMO], 1u); break; } } } } while (0)
struct XcdBarrier { unsigned* bar; unsigned x; volatile LAS unsigned* st; };
__device__ __forceinline__ XcdBarrier xcd_barrier_post(unsigned* bar, volatile LAS unsigned* st) {
    XcdBarrier b; b.bar = bar; b.x = xb_xcc_id(); b.st = st;
    if (threadIdx.x == 0) (void)xb_add(&bar[XB_XCNT(b.x)], 1u);
    return b;
}
__device__ __forceinline__ void xcd_barrier_complete(unsigned* bar, unsigned x, unsigned& nloc, unsigned& nx) {
    const unsigned G = gridDim.x * gridDim.y * gridDim.z;
    unsigned sum, cnt, mine, sp = 0u;
    for (;;) {
        sum = 0u; cnt = 0u; mine = 0u;
#pragma unroll
        for (unsigned j = 0; j < 16; ++j) { const unsigned c = xb_ld(&bar[XB_XCNT(j)]); sum += c; cnt += (c > 0u) ? 1u : 0u; mine = (j == x) ? c : mine; }
        if (sum == G) break;
        __builtin_amdgcn_s_sleep(1);
        if ((++sp & 255u) == 0u) { if (xb_ld(&bar[XB_TMO])) break; if (sp > XB_SPIN_CAP) { atomicAdd(&bar[XB_TMO], 1u); break; } }
    }
    nloc = mine > 0u ? mine : 1u; nx = cnt > 0u ? cnt : 1u;
}
__device__ __forceinline__ void xcd_barrier(const XcdBarrier& b, bool nowait = false) {
    asm volatile("s_waitcnt vmcnt(0)" ::: "memory");
    __syncthreads();
    if (threadIdx.x == 0) {
        unsigned* bar = b.bar; asm volatile("" : "+s"(bar));
        __builtin_amdgcn_s_waitcnt(0);
        if (b.st[3] != 0u) { const unsigned pg = b.st[2]; XB_SPIN(xb_ld(&bar[XB_XGEN(b.x)]) == pg, bar); __builtin_amdgcn_fence(__ATOMIC_ACQUIRE, "agent"); b.st[3] = 0u; }
        unsigned nloc = b.st[0], nx = b.st[1];
        if (nloc == 0u) { xcd_barrier_complete(bar, b.x, nloc, nx); b.st[0] = nloc; b.st[1] = nx; }
        const unsigned old = xb_add(&bar[XB_XSUB(b.x)], 1u);
        const unsigned gen = old / nloc;
        if (old + 1u == (gen + 1u) * nloc) {
            __builtin_amdgcn_fence(__ATOMIC_RELEASE, "agent");
            asm volatile("s_waitcnt vmcnt(0)" ::: "memory");
            const unsigned og = xb_add(&bar[XB_TOP], 1u);
            const unsigned tg = og / nx;
            if (og + 1u == (tg + 1u) * nx) xb_add(&bar[XB_TOPGEN], 1u);
            else XB_SPIN(xb_ld(&bar[XB_TOPGEN]) == tg, bar);
            __builtin_amdgcn_fence(__ATOMIC_ACQUIRE, "agent");
            xb_add(&bar[XB_XGEN(b.x)], 1u);
            asm volatile("s_waitcnt vmcnt(0)" ::: "memory");
        } else if (nowait) { b.st[2] = gen; b.st[3] = 1u; }
        else {
            XB_SPIN(xb_ld(&bar[XB_XGEN(b.x)]) == gen, bar);
            __builtin_amdgcn_fence(__ATOMIC_ACQUIRE, "agent");
            asm volatile("s_waitcnt vmcnt(0)" ::: "memory");
        }
    }
    __syncthreads();
}

#ifndef SIMPLE_GEMM
#define SIMPLE_GEMM 0
#endif
#ifndef MK_N_LAUNCHES
#define MK_N_LAUNCHES 1
#endif
constexpr int N_PHASES = 8 * kL + 1;
constexpr int RING_BYTES = 131072, LDS_BYTES = 163840, MISC_OFF = LDS_BYTES - 256;
static_assert(3 * CL_BYTES <= MISC_OFF && SL_END <= MISC_OFF && PL_END <= MISC_OFF, "lds map");
constexpr int CW_BAR = 4096;
constexpr int CW_CNT = CW_BAR + XCD_BAR_WORDS, CNT_WORDS = 2 * kL * 256;
#ifndef FUSE_NORM
#define FUSE_NORM 1
#endif
__global__ void __launch_bounds__(512, 2) fwd_kernel(Args args) {
    extern __shared__ __attribute__((aligned(16))) unsigned char lds[];
    Frame F;
    F.lds = (LAS unsigned char*)lds;
    F.tid = threadIdx.x; F.lane = F.tid & 63; F.wave = __builtin_amdgcn_readfirstlane(F.tid >> 6); F.G = gridDim.x; F.bid = blockIdx.x;
    int wave_s = F.wave; asm volatile("" : "+s"(wave_s));
    F.ka = ka_fresh();
    unsigned char* ws = args.ws;
    volatile LAS unsigned* MISC = (volatile LAS unsigned*)(F.lds + MISC_OFF);
    if (F.tid < 32) MISC[F.tid] = 0u;
    __syncthreads();
    const int lo = args.ph_lo, hi = args.ph_hi;
    XcdBarrier bar; bar.bar = (unsigned*)(ws + WS_CTL) + CW_BAR; bar.x = 0; bar.st = nullptr;
    if (hi - lo > 1) bar = xcd_barrier_post((unsigned*)(ws + WS_CTL) + CW_BAR, MISC + 8);
#ifndef PHMASK
#define PHMASK 0xFFFF
#endif
#define IN(p) (lo <= (p) && (p) < hi)
#define PHASE_BEGIN() do { F.ka = ka_fresh(); int tz_; asm volatile("v_mbcnt_lo_u32_b32 %0, -1, 0\n\tv_mbcnt_hi_u32_b32 %0, -1, %0" : "=v"(tz_)); tz_ += wave_s * 64; F.tid = tz_; F.lane = tz_ & 63; F.wave = __builtin_amdgcn_readfirstlane(tz_ >> 6); } while (0)
#define EN(k) ((PHMASK >> (k)) & 1)
#ifndef REPMASK
#define REPMASK 0
#endif
#define REP(k) (1 + ((REPMASK >> (k)) & 1))
#define SEAM(p) do { if (IN(p) && IN((p) + 1)) xcd_barrier(bar); else __syncthreads(); } while (0)
#pragma unroll 1
    for (int l = 0; l < kL; ++l) {
        const int p0 = 8 * l;
        if (IN(p0)) { PHASE_BEGIN();
            if (EN(0)) { if (l == 0) { init_phase(F); norm_phase<0>(F, nullptr, 4);
                if (F.wave >= 4) for (int it = F.bid * 4 + (F.wave - 4); it < CV_N0 + CV_N1; it += F.G * 4) conv_wave_tile(F, 0, it, F.lane); }
            else if (!FUSE_NORM) norm_phase<1>(F, F.in(I_NQF) + (l - 1) * kD); }
        }
        if (l == 0 || !FUSE_NORM) SEAM(p0);
        if (EN(2) && IN(p0 + 1) && (SIMPLE_GEMM & 1)) { PHASE_BEGIN(); simple_gemm_phase<0>(F, F.HB(), F.WinT(l), kM, kNP, kD, F.P(), kNP); }
        else if (EN(2) && IN(p0 + 1)) { PHASE_BEGIN(); pg8::Gemm g{F.HB(), F.WinT(l), kM, kNP, kD}; pg8::StaticOrder S; S.init(kM, kNP, F.G, F.bid); pg8::EpiBf16<true> E{F.P(), kNP, F.R2(), (LAS float*)(F.lds + RING_BYTES)};
            pg8::gemm_phase<pg8::EpiBf16<true>, pg8::StaticOrder, true, true>(F.lds, g, S, E, F.tid); }
        SEAM(p0 + 1);
        for (int rep_ = 0; rep_ < REP(3); ++rep_) { if (EN(3) && IN(p0 + 2)) { PHASE_BEGIN(); prep_phase(F, l); } }
        if (IN(p0 + 2) && IN(p0 + 3)) xcd_barrier(bar, F.G == 2 * kB * kH && F.bid >= kB * kH); else __syncthreads();
        for (int rep_ = 0; rep_ < REP(4); ++rep_) { if (EN(4) && IN(p0 + 3)) { PHASE_BEGIN(); mix_phase(F, l); } }
        SEAM(p0 + 3);
        if (EN(5) && IN(p0 + 4) && (SIMPLE_GEMM & 2)) { PHASE_BEGIN(); simple_gemm_phase<0>(F, F.O(), F.WoutT(l), kM, kD, kD, F.Y(), kD); }
        else if (EN(5) && IN(p0 + 4) && FUSE_NORM) { PHASE_BEGIN(); pg8::Gemm g{F.O(), F.WoutT(l), kM, kD, kD}; pg8::PanelOrder S; S.init(kM, F.G, F.bid);
            float* xp = (float*)(F.ws() + WS_Y + 160 * MiB); unsigned* ctl = (unsigned*)(F.ws() + WS_CTL);
            pg8::EpiResNorm<false> E{nullptr, F.HB(), F.in(I_NQM) + l * kD, xp, xp + (size_t)kM * 8, F.R2(), ctl + CW_CNT + (2 * l) * 256, ctl + CW_BAR + XB_TMO, (LAS float*)(F.lds + RING_BYTES)};
            pg8::gemm_phase<pg8::EpiResNorm<false>, pg8::PanelOrder, true, true>(F.lds, g, S, E, F.tid); }
        else if (EN(5) && IN(p0 + 4)) { PHASE_BEGIN(); pg8::Gemm g{F.O(), F.WoutT(l), kM, kD, kD}; pg8::StaticOrder S; S.init(kM, kD, F.G, F.bid); pg8::EpiBf16<false> E{F.Y(), kD, nullptr, nullptr};
            pg8::gemm_phase<pg8::EpiBf16<false>, pg8::StaticOrder, true, true>(F.lds, g, S, E, F.tid); }
        SEAM(p0 + 4);
        if (!FUSE_NORM) { if (EN(6) && IN(p0 + 5)) { PHASE_BEGIN(); norm_phase<1>(F, F.in(I_NQM) + l * kD); }
        SEAM(p0 + 5); }
        if (EN(7) && IN(p0 + 6) && (SIMPLE_GEMM & 4)) { PHASE_BEGIN(); simple_gemm_phase<1>(F, F.HB(), F.WguT(l), kM, 2 * kFF, kD, F.P(), kFF); }
        else if (EN(7) && IN(p0 + 6)) { PHASE_BEGIN(); pg8::Gemm g{F.HB(), F.WguT(l), kM, 2 * kFF, kD}; pg8::StaticOrder S; S.init(kM, 2 * kFF, F.G, F.bid); pg8::EpiSwiGlu E{F.P(), kFF, F.R2(), (LAS float*)(F.lds + RING_BYTES)};
            pg8::gemm_phase<pg8::EpiSwiGlu, pg8::StaticOrder, true, true>(F.lds, g, S, E, F.tid); }
        SEAM(p0 + 6);
        if (EN(8) && IN(p0 + 7) && (SIMPLE_GEMM & 8)) { PHASE_BEGIN(); simple_gemm_phase<0>(F, F.P(), F.WdT(l), kM, kD, kFF, F.Y(), kD); }
        else if (EN(8) && IN(p0 + 7) && FUSE_NORM && l + 1 < kL) { PHASE_BEGIN(); pg8::Gemm g{F.P(), F.WdT(l), kM, kD, kFF}; pg8::PanelOrder S; S.init(kM, F.G, F.bid);
            float* xp = (float*)(F.ws() + WS_Y + 160 * MiB); unsigned* ctl = (unsigned*)(F.ws() + WS_CTL);
            pg8::EpiResNorm<false> E{nullptr, F.HB(), F.in(I_NQF) + l * kD, xp, xp + (size_t)kM * 8, F.R2(), ctl + CW_CNT + (2 * l + 1) * 256, ctl + CW_BAR + XB_TMO, (LAS float*)(F.lds + RING_BYTES)};
            pg8::gemm_phase<pg8::EpiResNorm<false>, pg8::PanelOrder, true, true>(F.lds, g, S, E, F.tid); }
        else if (EN(8) && IN(p0 + 7) && FUSE_NORM) { PHASE_BEGIN(); pg8::Gemm g{F.P(), F.WdT(l), kM, kD, kFF}; pg8::PanelOrder S; S.init(kM, F.G, F.bid);
            float* xp = (float*)(F.ws() + WS_Y + 160 * MiB); unsigned* ctl = (unsigned*)(F.ws() + WS_CTL);
            pg8::EpiResNorm<true> E{F.out(), F.HB(), F.in(I_NQF) + l * kD, xp, xp + (size_t)kM * 8, F.R2(), ctl + CW_CNT + (2 * l + 1) * 256, ctl + CW_BAR + XB_TMO, (LAS float*)(F.lds + RING_BYTES)};
            pg8::gemm_phase<pg8::EpiResNorm<true>, pg8::PanelOrder, true, true>(F.lds, g, S, E, F.tid); }
        else if (EN(8) && IN(p0 + 7)) { PHASE_BEGIN(); pg8::Gemm g{F.P(), F.WdT(l), kM, kD, kFF}; pg8::StaticOrder S; S.init(kM, kD, F.G, F.bid); pg8::EpiBf16<false> E{F.Y(), kD, nullptr, nullptr};
            pg8::gemm_phase<pg8::EpiBf16<false>, pg8::StaticOrder, true, true>(F.lds, g, S, E, F.tid); }
        if (!FUSE_NORM || l + 1 < kL) SEAM(p0 + 7);
    }
    if (!FUSE_NORM && IN(8 * kL)) { PHASE_BEGIN(); norm_phase<2>(F, F.in(I_NQF) + (kL - 1) * kD); }
#undef IN
#undef SEAM
}

extern "C" void kernel_launch(void* const* d_in, const int* in_sizes, int n_in, void* d_out, int out_size, void* d_ws, size_t ws_size, hipStream_t stream) {
    static int grid = 0;
    if (grid == 0) {
        if (n_in != 31 || out_size != kM * kD || ws_size < WS_END) { fprintf(stderr, "kernel_launch: unexpected shapes (n_in %d out %d ws %zu need %zu)\n", n_in, out_size, ws_size, (size_t)WS_END); grid = -1; return; }
        int dev = 0, cus = 0, per_cu = 0;
        if (hipGetDevice(&dev) != hipSuccess || hipDeviceGetAttribute(&cus, hipDeviceAttributeMultiprocessorCount, dev) != hipSuccess) { grid = -1; return; }
        if (hipFuncSetAttribute((const void*)fwd_kernel, hipFuncAttributeMaxDynamicSharedMemorySize, LDS_BYTES) != hipSuccess) { fprintf(stderr, "kernel_launch: hipFuncSetAttribute failed\n"); grid = -1; return; }
        if (hipOccupancyMaxActiveBlocksPerMultiprocessor(&per_cu, (const void*)fwd_kernel, 512, LDS_BYTES) != hipSuccess || per_cu < 1) { fprintf(stderr, "kernel_launch: occupancy query says %d\n", per_cu); }
        (void)hipGetLastError();
        grid = cus;
    }
    if (grid < 0) return;
    (void)hipMemsetAsync((char*)d_ws + WS_CTL + (size_t)CW_BAR * 4, 0, (size_t)(XCD_BAR_WORDS + CNT_WORDS) * 4, stream);
    Args a{};
    for (int i = 0; i < 31; ++i) a.in[i] = (const float*)d_in[i];
    a.out = (float*)d_out; a.ws = (unsigned char*)d_ws;
    constexpr int NL = MK_N_LAUNCHES;
    for (int li = 0; li < NL; ++li) {
        a.ph_lo = (int)((long)N_PHASES * li / NL); a.ph_hi = (int)((long)N_PHASES * (li + 1) / NL);
        hipLaunchKernelGGL(fwd_kernel, dim3(grid), dim3(512), LDS_BYTES, stream, a);
    }
}
#endif
```
